# Optimizing an MI355X kernel written in HIP

```python
import jax, jax.numpy as jnp
from jax import lax
import numpy as np

D_MODEL = 1024
BATCH = 4
SEQ = 8192
DEPTH = 4
DEC_BATCH = 2
DEC_SEQ = 8192
PAST_LEN = 128

QK_NOPE_DIM = 128
QK_ROPE_DIM = 64
V_HEAD_DIM = 128
N_HEADS = D_MODEL // V_HEAD_DIM
ATTN_WIDTH = N_HEADS * V_HEAD_DIM
Q_LORA_RANK = 256
KV_LORA_RANK = 128
ROPE_THETA = 10000.0
Q_BLOCK = 128
POOL_WINDOWS = (2, 4, 8, 16)
N_POOL_GROUPS = 4
POOL_WIDTH = D_MODEL
POOL_GROUP = POOL_WIDTH // N_POOL_GROUPS
IN_WIDTH = Q_LORA_RANK + KV_LORA_RANK + QK_ROPE_DIM + POOL_WIDTH + ATTN_WIDTH + POOL_WIDTH
D_FF = 2816
N_MOD = 9
EPS = 1e-6

kernel_name = 'hybrid_mla_pool_macaron_encoder'


def rmsnorm(x, g):
    x32 = x.astype(jnp.float32)
    y = x32 * lax.rsqrt(jnp.mean(x32 * x32, axis=-1, keepdims=True) + EPS) * g.astype(jnp.float32)
    return y.astype(x.dtype)


def modulate(h, shift, scale):
    return h * (1 + scale) + shift


def swiglu(h, w_gu, w_down):
    gu = h @ w_gu
    gate, up = gu[..., :D_FF], gu[..., D_FF:]
    return (jax.nn.silu(gate) * up) @ w_down


def rope_tables(seq_len, dtype):
    inv = 1.0 / (ROPE_THETA ** (jnp.arange(0, QK_ROPE_DIM, 2, dtype=jnp.float32) / QK_ROPE_DIM))
    ang = jnp.arange(seq_len, dtype=jnp.float32)[:, None] * inv[None, :]
    ang = jnp.concatenate([ang, ang], axis=-1)
    return jnp.cos(ang).astype(dtype), jnp.sin(ang).astype(dtype)


def apply_rope(x, cos, sin):
    x1, x2 = x[..., :QK_ROPE_DIM // 2], x[..., QK_ROPE_DIM // 2:]
    return x * cos + jnp.concatenate([-x2, x1], axis=-1) * sin


def latent_attention(q_nope, q_rope, k_nope, k_rope, v):
    B, S, H, _ = q_nope.shape
    nb = S // Q_BLOCK
    scale = (QK_NOPE_DIM + QK_ROPE_DIM) ** -0.5

    def to_blocks(t):
        return jnp.moveaxis(t.reshape(B, nb, Q_BLOCK, *t.shape[2:]), 1, 0)

    def attend(blk):
        qn, qr = blk
        s = (jnp.einsum('bqhd,bkhd->bhqk', qn, k_nope).astype(jnp.float32)
             + jnp.einsum('bqhd,bkd->bhqk', qr, k_rope).astype(jnp.float32))
        p = jax.nn.softmax(s * scale, axis=-1).astype(v.dtype)
        return jnp.einsum('bhqk,bkhd->bqhd', p, v)

    o = lax.map(attend, (to_blocks(q_nope), to_blocks(q_rope)))
    return jnp.moveaxis(o, 0, 1).reshape(B, S, H * V_HEAD_DIM)


def multiscale_pool(u, w_pool, pool_scale):
    B, S, _ = u.shape
    u32 = u.astype(jnp.float32).reshape(B, S, N_POOL_GROUPS, POOL_GROUP)
    cs = jnp.concatenate([jnp.zeros((B, 1, N_POOL_GROUPS, POOL_GROUP), jnp.float32),
                          jnp.cumsum(u32, axis=1)], axis=1)
    half = jnp.array(POOL_WINDOWS, dtype=jnp.int32) // 2
    t = jnp.arange(S, dtype=jnp.int32)[:, None]
    lo = jnp.clip(t - half[None, :], 0, S)
    hi = jnp.clip(t + half[None, :], 0, S)
    g = jnp.arange(N_POOL_GROUPS, dtype=jnp.int32)[None, :]
    win_sum = cs[:, hi, g, :] - cs[:, lo, g, :]
    mean = win_sum / (hi - lo).astype(jnp.float32)[None, :, :, None]
    pooled = (mean - u32).astype(u.dtype)
    mixed = jnp.einsum('bsgc,gcd->bsgd', pooled, w_pool).reshape(B, S, POOL_WIDTH)
    return mixed * pool_scale


def hybrid_mixer(h, cos, sin, w_in, q_a_norm, w_qb, kv_a_norm, w_kvb, w_pool, pool_scale, w_out):
    B, S, _ = h.shape
    z = h @ w_in
    o1 = Q_LORA_RANK
    o2 = o1 + KV_LORA_RANK
    o3 = o2 + QK_ROPE_DIM
    o4 = o3 + POOL_WIDTH
    q_a, kv_a, k_rope, u, gate_logits = z[..., :o1], z[..., o1:o2], z[..., o2:o3], z[..., o3:o4], z[..., o4:]
    q = (rmsnorm(q_a, q_a_norm) @ w_qb).reshape(B, S, N_HEADS, QK_NOPE_DIM + QK_ROPE_DIM)
    q_nope, q_rope = q[..., :QK_NOPE_DIM], q[..., QK_NOPE_DIM:]
    kv = (rmsnorm(kv_a, kv_a_norm) @ w_kvb).reshape(B, S, N_HEADS, QK_NOPE_DIM + V_HEAD_DIM)
    k_nope, v = kv[..., :QK_NOPE_DIM], kv[..., QK_NOPE_DIM:]
    q_rope = apply_rope(q_rope, cos[:, None, :], sin[:, None, :])
    k_rope = apply_rope(k_rope, cos, sin)
    o_attn = latent_attention(q_nope, q_rope, k_nope, k_rope, v)
    o_pool = multiscale_pool(u, w_pool, pool_scale)
    gates = jax.nn.sigmoid(gate_logits)
    g_attn, g_pool = gates[..., :ATTN_WIDTH], gates[..., ATTN_WIDTH:]
    return (g_attn * o_attn + g_pool * o_pool) @ w_out


def encoder_trunk(x, c, w_ada, b_ada, n1_pre, w1_gu, w1_down, n1_post,
                  nm_pre, w_in, q_a_norm, w_qb, kv_a_norm, w_kvb, w_pool, pool_scale, w_out, nm_post,
                  n2_pre, w2_gu, w2_down, n2_post):
    B, S, D = x.shape
    cos, sin = rope_tables(S, x.dtype)
    for l in range(DEPTH):
        mod = (jax.nn.silu(c) @ w_ada[l] + b_ada[l]).reshape(B, N_MOD, D)[:, :, None, :]
        h = modulate(rmsnorm(x, n1_pre[l]), mod[:, 0], mod[:, 1])
        x = x + 0.5 * mod[:, 2] * rmsnorm(swiglu(h, w1_gu[l], w1_down[l]), n1_post[l])
        h = modulate(rmsnorm(x, nm_pre[l]), mod[:, 3], mod[:, 4])
        m = hybrid_mixer(h, cos, sin, w_in[l], q_a_norm[l], w_qb[l], kv_a_norm[l], w_kvb[l],
                         w_pool[l], pool_scale[l], w_out[l])
        x = x + mod[:, 5] * rmsnorm(m, nm_post[l])
        h = modulate(rmsnorm(x, n2_pre[l]), mod[:, 6], mod[:, 7])
        x = x + 0.5 * mod[:, 8] * rmsnorm(swiglu(h, w2_gu[l], w2_down[l]), n2_post[l])
    return x


def setup_inputs(seed: int = 0) -> dict:
    key = jax.random.key(seed)
    ks = jax.random.split(key, 32)
    f32 = jnp.float32
    L, D = DEPTH, D_MODEL

    def nrm(k, shape, scale):
        return jax.random.normal(k, shape, f32) * scale

    def gain(k, shape):
        return 1.0 + 0.02 * jax.random.normal(k, shape, f32)

    return {
        'x_prompt': nrm(ks[0], (BATCH, SEQ, D), 1.0),
        'x_sample': nrm(ks[1], (DEC_BATCH, DEC_SEQ, D), 1.0),
        'c_prompt': nrm(ks[2], (BATCH, D), 1.0),
        'c_sample': nrm(ks[3], (DEC_BATCH, D), 1.0),
        'w_ada': nrm(ks[4], (L, D, N_MOD * D), 0.3 * D ** -0.5),
        'b_ada': nrm(ks[5], (L, N_MOD * D), 0.02),
        'n1_pre': gain(ks[6], (L, D)),
        'w1_gu': nrm(ks[7], (L, D, 2 * D_FF), D ** -0.5),
        'w1_down': nrm(ks[8], (L, D_FF, D), D_FF ** -0.5),
        'n1_post': gain(ks[9], (L, D)),
        'nm_pre': gain(ks[10], (L, D)),
        'w_in': nrm(ks[11], (L, D, IN_WIDTH), D ** -0.5),
        'q_a_norm': gain(ks[12], (L, Q_LORA_RANK)),
        'w_qb': nrm(ks[13], (L, Q_LORA_RANK, N_HEADS * (QK_NOPE_DIM + QK_ROPE_DIM)), Q_LORA_RANK ** -0.5),
        'kv_a_norm': gain(ks[14], (L, KV_LORA_RANK)),
        'w_kvb': nrm(ks[15], (L, KV_LORA_RANK, N_HEADS * (QK_NOPE_DIM + V_HEAD_DIM)), KV_LORA_RANK ** -0.5),
        'w_pool': nrm(ks[16], (L, N_POOL_GROUPS, POOL_GROUP, POOL_GROUP), POOL_GROUP ** -0.5),
        'pool_scale': 1.0 + 0.05 * jax.random.normal(ks[17], (L, POOL_WIDTH), f32),
        'w_out': nrm(ks[18], (L, D, D), D ** -0.5),
        'nm_post': gain(ks[19], (L, D)),
        'n2_pre': gain(ks[20], (L, D)),
        'w2_gu': nrm(ks[21], (L, D, 2 * D_FF), D ** -0.5),
        'w2_down': nrm(ks[22], (L, D_FF, D), D_FF ** -0.5),
        'n2_post': gain(ks[23], (L, D)),
    }


def reference(x_prompt, x_sample, c_prompt, c_sample, w_ada, b_ada, n1_pre, w1_gu, w1_down, n1_post,
              nm_pre, w_in, q_a_norm, w_qb, kv_a_norm, w_kvb, w_pool, pool_scale, w_out, nm_post,
              n2_pre, w2_gu, w2_down, n2_post):
    y_prompt = encoder_trunk(x_prompt, c_prompt, w_ada, b_ada, n1_pre, w1_gu, w1_down, n1_post,
                             nm_pre, w_in, q_a_norm, w_qb, kv_a_norm, w_kvb, w_pool, pool_scale, w_out, nm_post,
                             n2_pre, w2_gu, w2_down, n2_post)
    y_sample = encoder_trunk(x_sample, c_sample, w_ada, b_ada, n1_pre, w1_gu, w1_down, n1_post,
                             nm_pre, w_in, q_a_norm, w_qb, kv_a_norm, w_kvb, w_pool, pool_scale, w_out, nm_post,
                             n2_pre, w2_gu, w2_down, n2_post)
    return (y_prompt, y_sample)
```

```cpp
#include <hip/hip_runtime.h>
#include <hip/hip_cooperative_groups.h>
#include <cstdio>
#include <cstdint>
namespace cg = cooperative_groups;

constexpr int DM = 1024, SEQ = 8192, NSEQ = 6, NTOK = NSEQ * SEQ, DEPTH = 4, DFF = 2816, NMOD = 9;
constexpr int NPROMPT_TOK = 4 * SEQ;
constexpr int NHEAD = 8, QLR = 256, KVLR = 128, ROPE = 64;
constexpr int INW = 3520, ZSW = 1536  , O4 = 1472;
constexpr int NCHUNK = 3, CSEQ = NSEQ / NCHUNK, CTOK = CSEQ * SEQ;
constexpr float EPS = 1e-6f;
constexpr int NTHREADS = 512;
constexpr int LDS_MISC = 157952;
constexpr int LDS_BYTES = 158720;

typedef unsigned short bf16_t;
typedef short bf16x8 __attribute__((ext_vector_type(8)));
typedef short s16x4 __attribute__((ext_vector_type(4)));
typedef float f32x4 __attribute__((ext_vector_type(4)));
typedef float f32x16 __attribute__((ext_vector_type(16)));
typedef unsigned u32x4 __attribute__((ext_vector_type(4)));
typedef unsigned u32x2 __attribute__((ext_vector_type(2)));

constexpr size_t MiB = 1u << 20;
constexpr size_t WS_MOD = 0;
constexpr size_t WS_COS = 1 * MiB;
constexpr size_t WS_SIN = 2 * MiB;
constexpr size_t WS_BAR = 3 * MiB, BAR_BYTES = 16384;
constexpr size_t WS_W = 4 * MiB;
constexpr size_t WS_H = 52 * MiB;
constexpr size_t WS_Y = 148 * MiB;
constexpr size_t WS_BIG = 244 * MiB;
constexpr size_t WS_ZS = WS_BIG + 280 * MiB;
constexpr size_t WS_END = WS_ZS + 144 * MiB;
constexpr size_t MX_ZS = 0;
constexpr size_t MX_QN = 48 * MiB;
constexpr size_t MX_KVN = 56 * MiB;
constexpr size_t MX_KR = 64 * MiB;
constexpr size_t MX_PL = 66 * MiB;
constexpr size_t MX_Q = 98 * MiB;
constexpr size_t MX_KV = 146 * MiB;
constexpr size_t MX_OA = 210 * MiB;
constexpr size_t MX_OP = 242 * MiB;
static_assert(CTOK == 16384, "mixer buffer map assumes 16384-token chunks");
constexpr size_t WO_1GU = 0, WO_1DN = WO_1GU + (size_t)2 * DFF * DM, WO_INA = WO_1DN + (size_t)DM * DFF, WO_ING = WO_INA + (size_t)ZSW * DM,
                 WO_QB = WO_ING + (size_t)2048 * DM, WO_KVB = WO_QB + (size_t)1536 * 256, WO_POOL = WO_KVB + (size_t)2048 * 256,
                 WO_OUT = WO_POOL + (size_t)1024 * 256, WO_2GU = WO_OUT + (size_t)DM * DM, WO_2DN = WO_2GU + (size_t)2 * DFF * DM,
                 WO_END = WO_2DN + (size_t)DM * DFF;
static_assert(WO_END * 2 <= 48 * MiB, "weights fit");

__device__ __forceinline__ float bf2f(unsigned short h) { return __builtin_bit_cast(float, (unsigned)h << 16); }
__device__ __forceinline__ unsigned f2bf(float f) { unsigned u = __builtin_bit_cast(unsigned, f); return (u + 0x7fffu + ((u >> 16) & 1u)) >> 16; }
__device__ __forceinline__ unsigned pk2(float lo, float hi) { return f2bf(lo) | (f2bf(hi) << 16); }
typedef float f32x2_t __attribute__((ext_vector_type(2)));
typedef __bf16 bf16x2_t __attribute__((ext_vector_type(2)));
__device__ __forceinline__ unsigned cvtpk(float lo, float hi) { f32x2_t v = {lo, hi}; bf16x2_t b = __builtin_convertvector(v, bf16x2_t); return __builtin_bit_cast(unsigned, b); }
__device__ __forceinline__ float sigmoidf_(float x) { return __builtin_amdgcn_rcpf(1.f + __builtin_amdgcn_exp2f(-x * 1.4426950408889634f)); }
__device__ __forceinline__ int tid_opaque() { int t = threadIdx.x; asm volatile("" : "+v"(t)); return t; }
__device__ __forceinline__ float shfl_xor_l(float v, int o, int lane) { return __builtin_bit_cast(float, __builtin_amdgcn_ds_bpermute((lane ^ o) << 2, __builtin_bit_cast(int, v))); }
__device__ __forceinline__ float wave_sum(float v, int lane) {
#pragma unroll
    for (int o = 32; o >= 1; o >>= 1) v += shfl_xor_l(v, o, lane);
    return v;
}

#define XB_TMO      128
#define XB_XCNT(j)  (256  + 64 * (j))
#define XB_XSUB(j)  (1280 + 64 * (j))
#define XB_XGEN(j)  (2304 + 64 * (j))
#define XB_TOP      3328
#define XB_TOPGEN   3392
#define XCD_BAR_WORDS 3456
#define XB_SPIN_CAP (1u << 22)
#define LAS __attribute__((address_space(3)))
__device__ __forceinline__ unsigned xb_ld(unsigned* p)              { return __hip_atomic_load(p, __ATOMIC_RELAXED, __HIP_MEMORY_SCOPE_AGENT); }
__device__ __forceinline__ unsigned xb_add(unsigned* p, unsigned v) { return __hip_atomic_fetch_add(p, v, __ATOMIC_RELAXED, __HIP_MEMORY_SCOPE_AGENT); }
__device__ __forceinline__ unsigned xb_xcc_id() { return (unsigned)__builtin_amdgcn_s_getreg((3 << 11) | 20) & 0xFu; }
#define XB_SPIN(cond, bar) do { unsigned _sp = 0; while (cond) { __builtin_amdgcn_s_sleep(1); \
    if ((++_sp & 255u) == 0u) { if (xb_ld(&(bar)[XB_TMO])) break; if (_sp > XB_SPIN_CAP) { atomicAdd(&(bar)[XB_TMO], 1u); break; } } } } while (0)
struct XcdBarrier { unsigned* bar; unsigned x; volatile LAS unsigned* st; };
__device__ __forceinline__ XcdBarrier xcd_barrier_post(unsigned* bar, volatile LAS unsigned* st) {
    XcdBarrier b; b.bar = bar; b.x = xb_xcc_id(); b.st = st;
    if (threadIdx.x == 0) (void)xb_add(&bar[XB_XCNT(b.x)], 1u);
    return b;
}
__device__ __forceinline__ void xcd_barrier_complete(unsigned* bar, unsigned x, unsigned& nloc, unsigned& nx) {
    const unsigned G = gridDim.x * gridDim.y * gridDim.z;
    unsigned sum, cnt, mine, sp = 0u;
    for (;;) {
        sum = 0u; cnt = 0u; mine = 0u;
#pragma unroll
        for (unsigned j = 0; j < 16; ++j) { const unsigned c = xb_ld(&bar[XB_XCNT(j)]); sum += c; cnt += (c > 0u) ? 1u : 0u; mine = (j == x) ? c : mine; }
        if (sum == G) break;
        __builtin_amdgcn_s_sleep(1);
        if ((++sp & 255u) == 0u) { if (xb_ld(&bar[XB_TMO])) break; if (sp > XB_SPIN_CAP) { atomicAdd(&bar[XB_TMO], 1u); break; } }
    }
    nloc = mine > 0u ? mine : 1u; nx = cnt > 0u ? cnt : 1u;
}
__device__ __forceinline__ void xcd_barrier(const XcdBarrier& b) {
    asm volatile("s_waitcnt vmcnt(0)" ::: "memory");
    __syncthreads();
    if (threadIdx.x == 0) {
        unsigned* bar = b.bar;
        __builtin_amdgcn_s_waitcnt(0);
        unsigned nloc = b.st[0], nx = b.st[1];
        if (nloc == 0u) { xcd_barrier_complete(bar, b.x, nloc, nx); b.st[0] = nloc; b.st[1] = nx; }
        const unsigned old = xb_add(&bar[XB_XSUB(b.x)], 1u);
        const unsigned gen = old / nloc;
        if (old + 1u == (gen + 1u) * nloc) {
            __builtin_amdgcn_fence(__ATOMIC_RELEASE, "agent");
            asm volatile("s_waitcnt vmcnt(0)" ::: "memory");
            const unsigned og = xb_add(&bar[XB_TOP], 1u);
            const unsigned tg = og / nx;
            if (og + 1u == (tg + 1u) * nx) xb_add(&bar[XB_TOPGEN], 1u);
            else XB_SPIN(xb_ld(&bar[XB_TOPGEN]) == tg, bar);
            __builtin_amdgcn_fence(__ATOMIC_ACQUIRE, "agent");
            xb_add(&bar[XB_XGEN(b.x)], 1u);
            asm volatile("s_waitcnt vmcnt(0)" ::: "memory");
        } else {
            XB_SPIN(xb_ld(&bar[XB_XGEN(b.x)]) == gen, bar);
            __builtin_amdgcn_fence(__ATOMIC_ACQUIRE, "agent");
            asm volatile("s_waitcnt vmcnt(0)" ::: "memory");
        }
    }
    __syncthreads();
}

namespace pg8 {
#define PG8_LAS __attribute__((address_space(3)))
constexpr int BM = 256, BK = 64, HALF = 128, HTB = HALF * BK * 2, STAGE_BYTES = 8 * HTB, NXCD = 8, WGM = 8;
__host__ __device__ __forceinline__ int lds_byte(int r, int c) { const int st = (r >> 4) * 2 + (c >> 5), rr = r & 15, cc = c & 31, ob = rr * 64 + cc * 2; return st * 1024 + (ob ^ (((ob >> 9) & 1) << 5)); }
__host__ __device__ __forceinline__ void stage_rc(int b, int& R, int& C) { const int st = b / 1024, sb = b % 1024, swz = sb ^ (((sb >> 9) & 1) << 5); R = (st >> 1) * 16 + swz / 64; C = (st & 1) * 32 + (swz % 64) / 2; }
__host__ __device__ __forceinline__ int perm32(int rho) { const int n = rho >> 4, i = rho & 15; return 8 * (i >> 2) + 4 * n + (i & 3); }
struct Unit { int pm, pn; };
struct Gemm { const bf16_t* A; const bf16_t* Bt; int M, N, K, lda, ldb, a_pn_off; };
struct StaticOrder {
    int nM, nN, nwg, G, c;
    __device__ void init(int M, int N, int G_, int c_) { nM = M / BM; nN = N / BM; nwg = nM * nN; G = G_; c = c_; }
    __device__ bool next(int i, Unit& u) const {
        const long L = (long)i * G + c; if (L >= nwg) return false;
        int wgid = (int)L; { const int q = nwg / NXCD, r = nwg % NXCD, xcd = wgid % NXCD, off = wgid / NXCD; wgid = (xcd < r ? xcd * (q + 1) : r * (q + 1) + (xcd - r) * q) + off; }
        const int nig = WGM * nN, gid = wgid / nig, fm = gid * WGM, gsz = (nM - fm) < WGM ? (nM - fm) : WGM;
        u.pm = fm + ((wgid % nig) % gsz); u.pn = (wgid % nig) / gsz; return true;
    }
};
template <int MODE> struct Epi {
    bf16_t* O; int ldc; const float* cs; const bf16_t* oa; const bf16_t* op; float sc;
    __device__ __forceinline__ void operator()(const f32x4 (&acc)[2][2][4][2], const Unit& u, int wr, int wc, int fr, int fq) const {
        const int row0 = u.pm * BM + wr * 64 + fr;
        if constexpr (MODE == 0) {
            const int col0 = u.pn * BM + wc * 32 + 8 * fq;
            f32x4 sv[2][2];
#pragma unroll
            for (int bj = 0; bj < 2; ++bj)
#pragma unroll
                for (int n = 0; n < 2; ++n) sv[bj][n] = (cs ? *(const f32x4*)(cs + col0 + bj * HALF + 4 * n) : (f32x4){1.f, 1.f, 1.f, 1.f}) * sc;
#pragma unroll
            for (int ai = 0; ai < 2; ++ai)
#pragma unroll
                for (int m = 0; m < 4; ++m) { bf16_t* rowp = O + (size_t)(row0 + ai * HALF + m * 16) * ldc + col0;
#pragma unroll
                    for (int bj = 0; bj < 2; ++bj) { const f32x4 v0 = acc[ai][bj][m][0] * sv[bj][0], v1 = acc[ai][bj][m][1] * sv[bj][1];
                        u32x4 w; w.x = cvtpk(v0[0], v0[1]); w.y = cvtpk(v0[2], v0[3]); w.z = cvtpk(v1[0], v1[1]); w.w = cvtpk(v1[2], v1[3]);
                        *(u32x4*)(rowp + bj * HALF) = w; } }
        } else {
            const int col0 = u.pn * HALF + wc * 32 + 8 * fq;
#pragma unroll
            for (int ai = 0; ai < 2; ++ai)
#pragma unroll
                for (int m = 0; m < 4; ++m) { const size_t ro = (size_t)(row0 + ai * HALF + m * 16) * ldc + col0;
                    float r[8];
                    if constexpr (MODE == 1) {
#pragma unroll
                        for (int n = 0; n < 2; ++n)
#pragma unroll
                            for (int j = 0; j < 4; ++j) { const float g = acc[ai][0][m][n][j], up = acc[ai][1][m][n][j]; r[n * 4 + j] = g * sigmoidf_(g) * up; }
                    } else {
                        const u32x4 a = *(const u32x4*)(oa + ro), b = *(const u32x4*)(op + ro);
#pragma unroll
                        for (int n = 0; n < 2; ++n)
#pragma unroll
                            for (int j = 0; j < 4; ++j) { const int e = n * 4 + j; const unsigned aw = a[e >> 1], bw = b[e >> 1];
                                const float av = (e & 1) ? __builtin_bit_cast(float, aw & 0xffff0000u) : __builtin_bit_cast(float, aw << 16);
                                const float bv = (e & 1) ? __builtin_bit_cast(float, bw & 0xffff0000u) : __builtin_bit_cast(float, bw << 16);
                                r[e] = sigmoidf_(acc[ai][0][m][n][j]) * av + sigmoidf_(acc[ai][1][m][n][j]) * bv; }
                    }
                    u32x4 w; w.x = cvtpk(r[0], r[1]); w.y = cvtpk(r[2], r[3]); w.z = cvtpk(r[4], r[5]); w.w = cvtpk(r[6], r[7]);
                    *(u32x4*)(O + ro) = w; }
        }
    }
};

template <class EpiT>
__device__ __forceinline__ void gemm_phase(PG8_LAS unsigned char* lds, const Gemm g, const StaticOrder& S, const EpiT& E) {
    const int tid = tid_opaque(), wid = __builtin_amdgcn_readfirstlane(tid >> 6), lane = tid & 63, wr = wid >> 2, wc = wid & 3, fr = lane & 15, fq = lane >> 4;
    const int K = g.K, nt = K / BK;
    const char* gA = (const char*)g.A; const char* gB = (const char*)g.Bt;
    asm volatile("" : "+s"(gA), "+s"(gB));
    unsigned voffA[2], voffB[2];
#pragma unroll
    for (int i = 0; i < 2; ++i) { int R, C; stage_rc(tid * 16 + i * 8192, R, C); const int Rb = (R & ~31) + perm32(R & 31);
        voffA[i] = (unsigned)(R * g.lda + C) * 2u; voffB[i] = (unsigned)(Rb * g.ldb + C) * 2u; }
    const __amdgpu_buffer_rsrc_t srdA = __builtin_amdgcn_make_buffer_rsrc((void*)gA, (short)0, 0x7fffffff, 0x00020000);
    const __amdgpu_buffer_rsrc_t srdB = __builtin_amdgcn_make_buffer_rsrc((void*)gB, (short)0, 0x7fffffff, 0x00020000);
    const unsigned kstep = (unsigned)(BK * 2);
    const unsigned hstepA = (unsigned)HALF * g.lda * 2u, hstepB = (unsigned)HALF * g.ldb * 2u;
    const unsigned tstepA = 2u * hstepA, tstepB = 2u * hstepB;
    const unsigned ldsw = (unsigned)wid * 1024u;
    const int aoff = lds_byte(wr * 64 + fr, fq * 8), boff = lds_byte(wc * 32 + fr, fq * 8);
#define PG8_SA(b, h) (((b) * 2 + (h)) * HTB)
#define PG8_SB(b, h) ((4 + (b) * 2 + (h)) * HTB)
#define PG8_STAGE(bufoff, srd, soff, voff) do { _Pragma("unroll") for (int _i = 0; _i < 2; ++_i) \
        __builtin_amdgcn_raw_ptr_buffer_load_lds(srd, (PG8_LAS unsigned*)(lds + (bufoff) + ldsw + _i * 8192), 16, (voff)[_i], (soff), 0, 0); } while (0)
#define PG8_LDA(dst, b, h) do { _Pragma("unroll") for (int m = 0; m < 4; ++m) _Pragma("unroll") for (int k = 0; k < 2; ++k) dst[m][k] = *(const PG8_LAS bf16x8*)(lds + PG8_SA(b, h) + aoff + m * 2048 + k * 1024); } while (0)
#define PG8_LDB(dst, b, h) do { _Pragma("unroll") for (int n = 0; n < 2; ++n) _Pragma("unroll") for (int k = 0; k < 2; ++k) dst[n][k] = *(const PG8_LAS bf16x8*)(lds + PG8_SB(b, h) + boff + n * 2048 + k * 1024); } while (0)
#define PG8_MMA(ai, bj, At, Bt) do { __builtin_amdgcn_s_setprio(1); _Pragma("unroll") for (int m = 0; m < 4; ++m) _Pragma("unroll") for (int n = 0; n < 2; ++n) _Pragma("unroll") for (int k = 0; k < 2; ++k) \
        acc[ai][bj][m][n] = __builtin_amdgcn_mfma_f32_16x16x32_bf16(Bt[n][k], At[m][k], acc[ai][bj][m][n], 0, 0, 0); __builtin_amdgcn_s_setprio(0); } while (0)
#define PG8_WAIT_V(n) asm volatile("s_waitcnt vmcnt(" #n ")" ::: "memory")
#define PG8_WAIT_L(n) asm volatile("s_waitcnt lgkmcnt(" #n ")" ::: "memory")
#define PG8_BAR __builtin_amdgcn_s_barrier()
#define PG8_SCHED __builtin_amdgcn_sched_barrier(0)
    Unit cur, nxt; int ui = 0;
    if (!S.next(0, cur)) return;
    f32x4 acc[2][2][4][2];
#pragma unroll
    for (int a = 0; a < 2; ++a)
#pragma unroll
        for (int b = 0; b < 2; ++b)
#pragma unroll
            for (int m = 0; m < 4; ++m)
#pragma unroll
                for (int n = 0; n < 2; ++n) acc[a][b][m][n] = (f32x4){0.f, 0.f, 0.f, 0.f};
    bf16x8 At[4][2], B0[2][2], B1[2][2];
    unsigned cA = (unsigned)cur.pm * tstepA + (unsigned)cur.pn * (unsigned)g.a_pn_off * 2u, cB = (unsigned)cur.pn * tstepB;
    PG8_STAGE(PG8_SB(0, 0), srdB, cB, voffB); PG8_STAGE(PG8_SB(0, 1), srdB, cB + hstepB, voffB); PG8_STAGE(PG8_SA(0, 0), srdA, cA, voffA); PG8_STAGE(PG8_SA(0, 1), srdA, cA + hstepA, voffA);
    if (wr == 1) PG8_BAR;
    PG8_WAIT_V(2); PG8_BAR;
    PG8_STAGE(PG8_SB(1, 0), srdB, cB + kstep, voffB); PG8_STAGE(PG8_SA(1, 0), srdA, cA + kstep, voffA); PG8_STAGE(PG8_SB(1, 1), srdB, cB + hstepB + kstep, voffB);
    PG8_WAIT_V(6); PG8_BAR;
    for (;;) {
        const bool has_next = S.next(ui + 1, nxt);
        const unsigned nA = has_next ? (unsigned)nxt.pm * tstepA + (unsigned)nxt.pn * (unsigned)g.a_pn_off * 2u : cA, nB = has_next ? (unsigned)nxt.pn * tstepB : cB;
        for (int t = 0; t < nt; t += 2) {
            const bool last = (t == nt - 2);
            const unsigned a1 = cA + (unsigned)(t + 1) * kstep;
            const unsigned a2 = last ? nA : cA + (unsigned)(t + 2) * kstep, b2 = last ? nB : cB + (unsigned)(t + 2) * kstep;
            const unsigned a3 = a2 + kstep, b3 = b2 + kstep;
            PG8_LDB(B0, 0, 0); PG8_LDB(B1, 0, 1); PG8_SCHED; PG8_LDA(At, 0, 0); PG8_STAGE(PG8_SA(1, 1), srdA, a1 + hstepA, voffA);
            PG8_WAIT_V(8); PG8_WAIT_L(0); PG8_BAR; PG8_MMA(0, 0, At, B0); PG8_MMA(0, 1, At, B1); PG8_BAR; PG8_SCHED;
            PG8_LDA(At, 0, 1); PG8_STAGE(PG8_SB(0, 0), srdB, b2, voffB); PG8_STAGE(PG8_SB(0, 1), srdB, b2 + hstepB, voffB); PG8_STAGE(PG8_SA(0, 0), srdA, a2, voffA);
            PG8_WAIT_V(8); PG8_WAIT_L(0); PG8_BAR; PG8_MMA(1, 0, At, B0); PG8_MMA(1, 1, At, B1); PG8_BAR; PG8_SCHED;
            PG8_LDB(B0, 1, 0); PG8_LDB(B1, 1, 1); PG8_SCHED; PG8_LDA(At, 1, 0); PG8_STAGE(PG8_SA(0, 1), srdA, a2 + hstepA, voffA);
            PG8_WAIT_V(8); PG8_WAIT_L(0); PG8_BAR; PG8_MMA(0, 0, At, B0); PG8_MMA(0, 1, At, B1); PG8_BAR; PG8_SCHED;
            PG8_LDA(At, 1, 1); PG8_STAGE(PG8_SB(1, 0), srdB, b3, voffB); PG8_STAGE(PG8_SB(1, 1), srdB, b3 + hstepB, voffB); PG8_STAGE(PG8_SA(1, 0), srdA, a3, voffA);
            PG8_WAIT_V(8); PG8_WAIT_L(0); PG8_BAR; PG8_MMA(1, 0, At, B0); PG8_MMA(1, 1, At, B1); PG8_BAR; PG8_SCHED;
        }
        if (wr == 0) PG8_BAR;
        E(acc, cur, wr, wc, fr, fq);
        if (!has_next) break;
#pragma unroll
        for (int a = 0; a < 2; ++a)
#pragma unroll
            for (int b = 0; b < 2; ++b)
#pragma unroll
                for (int m = 0; m < 4; ++m)
#pragma unroll
                    for (int n = 0; n < 2; ++n) acc[a][b][m][n] = (f32x4){0.f, 0.f, 0.f, 0.f};
        cur = nxt; cA = nA; cB = nB; ++ui;
        if (wr == 1) PG8_BAR;
    }
    PG8_WAIT_V(0);
    PG8_BAR;
#undef PG8_SA
#undef PG8_SB
#undef PG8_STAGE
#undef PG8_LDA
#undef PG8_LDB
#undef PG8_MMA
#undef PG8_WAIT_V
#undef PG8_WAIT_L
#undef PG8_BAR
#undef PG8_SCHED
}
}

namespace att {
constexpr int NW = 8, QBLK = 32, KVBLK = 64;
constexpr float SCALE = 0.07216878364870322f;
constexpr float THR = 8.f;
constexpr float QSCALE = SCALE * 1.4426950408889634f;
constexpr float THRL = THR * 1.4426950408889634f;
constexpr int LDQ = 1536, LDK = 2048, LDKR = 64, LDO = 1024;
constexpr int SHM_V = KVBLK * 128 * 2, SHM_K = KVBLK * 128 * 2, SHM_KR = KVBLK * 64 * 2;
constexpr int NBUF = 3;
constexpr int OFF_V = 0, OFF_K = NBUF * SHM_V, OFF_KR = OFF_K + NBUF * SHM_K, OFF_WS = OFF_KR + NBUF * SHM_KR, OFF_Q = OFF_WS + NW * 64 * 4, SHM_ATTN = OFF_Q + NW * 4 * 1024;
static_assert(SHM_ATTN <= LDS_MISC, "attention LDS fits below the barrier words");
#ifndef ATT_SDEPTH
#define ATT_SDEPTH 1
#endif
constexpr int SDEPTH = ATT_SDEPTH;
#define KSWZ(row, colB) ((row) * 256 + ((colB) ^ (((row) & 15) << 4)))
#define KRSWZ(row, colB) ((row) * 128 + ((colB) ^ ((((row) >> 1) & 7) << 4)))
#define SBAR() __builtin_amdgcn_sched_barrier(0)
__device__ __forceinline__ int crow(int r, int hi) { return (r & 3) + 8 * (r >> 2) + 4 * hi; }

template <bool FIRST> __device__ __forceinline__ void partialSM(f32x16& p0, f32x16& p1, f32x16& negm, float& alpha) {
    float pmax = p0[0];
#pragma unroll
    for (int r = 1; r < 16; ++r) pmax = fmaxf(pmax, p0[r]);
#pragma unroll
    for (int r = 0; r < 16; ++r) pmax = fmaxf(pmax, p1[r]);
    { auto rr = __builtin_amdgcn_permlane32_swap(__float_as_uint(pmax), __float_as_uint(pmax), false, false);
      pmax = fmaxf(__uint_as_float(rr[0]), __uint_as_float(rr[1])); }
    if (!FIRST && __builtin_expect(__all(pmax <= THRL), 1)) { alpha = 1.f; }
    else { const float d = FIRST ? pmax : fmaxf(pmax, 0.f); alpha = FIRST ? 1.f : __builtin_amdgcn_exp2f(-d);
#pragma unroll
        for (int r = 0; r < 16; ++r) { p0[r] -= d; p1[r] -= d; negm[r] -= d; } }
#pragma unroll
    for (int r = 0; r < 16; ++r) p0[r] = __builtin_amdgcn_exp2f(p0[r]);
}
__device__ __forceinline__ void finishSM(f32x16& p0, f32x16& p1, float alpha, float& l_reg, bf16x8& pa0, bf16x8& pa1, bf16x8& pa2, bf16x8& pa3) {
#pragma unroll
    for (int r = 0; r < 16; ++r) p1[r] = __builtin_amdgcn_exp2f(p1[r]);
    float ps = 0;
#pragma unroll
    for (int r = 0; r < 16; ++r) ps += p0[r];
#pragma unroll
    for (int r = 0; r < 16; ++r) ps += p1[r];
    { auto rr = __builtin_amdgcn_permlane32_swap(__float_as_uint(ps), __float_as_uint(ps), false, false);
      ps = __uint_as_float(rr[0]) + __uint_as_float(rr[1]); }
    l_reg = l_reg * alpha + ps;
#define PK4(P, BASE, OUT) do { unsigned a0 = cvtpk(P[BASE + 0], P[BASE + 1]), a1 = cvtpk(P[BASE + 2], P[BASE + 3]);   \
    unsigned b0 = cvtpk(P[BASE + 4], P[BASE + 5]), b1 = cvtpk(P[BASE + 6], P[BASE + 7]);                              \
    auto r0 = __builtin_amdgcn_permlane32_swap(a0, b0, false, false); auto r1 = __builtin_amdgcn_permlane32_swap(a1, b1, false, false); \
    u32x4 w = {r0[0], r1[0], r0[1], r1[1]}; OUT = __builtin_bit_cast(bf16x8, w); } while (0)
    PK4(p0, 0, pa0); PK4(p0, 8, pa1); PK4(p1, 0, pa2); PK4(p1, 8, pa3);
#undef PK4
}
#define LDSP(T, a) ((__attribute__((address_space(3))) T*)(uintptr_t)(a))
__device__ __forceinline__ void qkt(f32x16& p0, f32x16& p1, unsigned Ks, unsigned Krs, const bf16x8* qr, unsigned QL, const f32x16& negm, int r32, int hi) {
    p0 = negm; p1 = negm;
#pragma unroll
    for (int d0 = 0; d0 < 8; ++d0) { int cb = (d0 * 16 + hi * 8) * 2;
        bf16x8 b0 = *LDSP(const bf16x8, Ks + KSWZ(r32, cb));
        bf16x8 b1 = *LDSP(const bf16x8, Ks + KSWZ(32 + r32, cb));
        p0 = __builtin_amdgcn_mfma_f32_32x32x16_bf16(b0, qr[d0], p0, 0, 0, 0);
        p1 = __builtin_amdgcn_mfma_f32_32x32x16_bf16(b1, qr[d0], p1, 0, 0, 0); }
#pragma unroll
    for (int d0 = 0; d0 < 4; ++d0) { int cb = (d0 * 16 + hi * 8) * 2;
        bf16x8 b0 = *LDSP(const bf16x8, Krs + KRSWZ(r32, cb));
        bf16x8 b1 = *LDSP(const bf16x8, Krs + KRSWZ(32 + r32, cb));
        p0 = __builtin_amdgcn_mfma_f32_32x32x16_bf16(b0, qr[8 + d0], p0, 0, 0, 0);
        p1 = __builtin_amdgcn_mfma_f32_32x32x16_bf16(b1, qr[8 + d0], p1, 0, 0, 0); }
}
__device__ __forceinline__ int v_st(int k, int c) { const int kk = (k & ~0xC) | ((k & 4) << 1) | ((k & 8) >> 1); return ((kk >> 3) * 4 + (c >> 5)) * 512 + ((kk & 7) * 32 + (c & 31)) * 2; }
__device__ __forceinline__ int v_rd_base(int lane) { return ((lane & 3) << 3) | (((lane >> 2) & 3) << 6) | (((lane >> 4) & 1) << 5) | (((lane >> 5) & 1) << 8); }
constexpr int v_rd_off(int d0, int ks, int half) { return d0 * 512 + ks * 4096 + half * 2048; }
typedef short v4i16_t __attribute__((ext_vector_type(4)));
template <int OFF> __device__ __forceinline__ s16x4 tr_read(int vb) {
    return __builtin_bit_cast(s16x4, __builtin_amdgcn_ds_read_tr16_b64_v4i16((__attribute__((address_space(3))) v4i16_t*)(uintptr_t)(unsigned)(vb + OFF)));
}
template <int KS> __device__ __forceinline__ void pv_slice(f32x16* o, int vb, bf16x8 pa) {
    const s16x4 l0 = tr_read<v_rd_off(0, KS, 0)>(vb), h0 = tr_read<v_rd_off(0, KS, 1)>(vb), l1 = tr_read<v_rd_off(1, KS, 0)>(vb), h1 = tr_read<v_rd_off(1, KS, 1)>(vb);
    const s16x4 l2 = tr_read<v_rd_off(2, KS, 0)>(vb), h2 = tr_read<v_rd_off(2, KS, 1)>(vb), l3 = tr_read<v_rd_off(3, KS, 0)>(vb), h3 = tr_read<v_rd_off(3, KS, 1)>(vb);
#define PK(L, H) (bf16x8){L[0], L[1], L[2], L[3], H[0], H[1], H[2], H[3]}
    o[0] = __builtin_amdgcn_mfma_f32_32x32x16_bf16(pa, PK(l0, h0), o[0], 0, 0, 0);
    o[1] = __builtin_amdgcn_mfma_f32_32x32x16_bf16(pa, PK(l1, h1), o[1], 0, 0, 0);
    o[2] = __builtin_amdgcn_mfma_f32_32x32x16_bf16(pa, PK(l2, h2), o[2], 0, 0, 0);
    o[3] = __builtin_amdgcn_mfma_f32_32x32x16_bf16(pa, PK(l3, h3), o[3], 0, 0, 0);
#undef PK
}
__device__ __forceinline__ void pv_d0(f32x16* o, int vb, bf16x8 pa0, bf16x8 pa1, bf16x8 pa2, bf16x8 pa3) {
    pv_slice<0>(o, vb, pa0); pv_slice<1>(o, vb, pa1); pv_slice<2>(o, vb, pa2); pv_slice<3>(o, vb, pa3);
}
__device__ __forceinline__ void rope8(bf16x8 a, bf16x8 b, const float* cs, const float* sn, bf16x8& oa, bf16x8& ob) {
    const f32x4 c0 = *(const f32x4*)cs, c1 = *(const f32x4*)(cs + 4), s0 = *(const f32x4*)sn, s1 = *(const f32x4*)(sn + 4);
    float r1[8], r2[8];
#pragma unroll
    for (int e = 0; e < 8; ++e) { const float x1 = bf2f((unsigned short)a[e]), x2 = bf2f((unsigned short)b[e]); const float c = e < 4 ? c0[e & 3] : c1[e & 3], s = e < 4 ? s0[e & 3] : s1[e & 3];
        r1[e] = x1 * c - x2 * s; r2[e] = x2 * c + x1 * s; }
    u32x4 w1 = {cvtpk(r1[0], r1[1]), cvtpk(r1[2], r1[3]), cvtpk(r1[4], r1[5]), cvtpk(r1[6], r1[7])};
    u32x4 w2 = {cvtpk(r2[0], r2[1]), cvtpk(r2[2], r2[3]), cvtpk(r2[4], r2[5]), cvtpk(r2[6], r2[7])};
    oa = __builtin_bit_cast(bf16x8, w1); ob = __builtin_bit_cast(bf16x8, w2);
}

__device__ __forceinline__ void attn_unit(const bf16_t* __restrict__ Qb, const bf16_t* __restrict__ Kh, const bf16_t* __restrict__ Vh, const bf16_t* __restrict__ Kr,
                                          bf16_t* __restrict__ Ob, const float* __restrict__ cosT, const float* __restrict__ sinT, int pos0, int seq, char* lds) {
    const int tid = tid_opaque(), wid = tid >> 6, lane = tid & 63, r32 = lane & 31, hi = lane >> 5;
    unsigned lbase = (unsigned)(uintptr_t)(__attribute__((address_space(3))) char*)lds;
    unsigned V_lds = lbase + OFF_V, K_lds = lbase + OFF_K, KR_lds = lbase + OFF_KR;
    asm volatile("" : "+s"(V_lds), "+s"(K_lds), "+s"(KR_lds));
    const unsigned QL = lbase + OFF_Q + wid * 4096 + lane * 16;
    float* ws = (float*)(lds + OFF_WS) + wid * 64; float* li_l = ws; float* al_l = ws + 32;
    float l_reg = 0; f32x16 o[4] = {}; f32x16 negm = {}; bf16x8 qr[12];
    const bf16_t* Qw = Qb + (size_t)(wid * QBLK + r32) * LDQ + hi * 8;
#pragma unroll
    for (int d0 = 0; d0 < 8; ++d0) qr[d0] = *reinterpret_cast<const bf16x8*>(Qw + d0 * 16);
    { const bf16x8 a0 = *reinterpret_cast<const bf16x8*>(Qw + 128), a1 = *reinterpret_cast<const bf16x8*>(Qw + 144),
                   b0 = *reinterpret_cast<const bf16x8*>(Qw + 160), b1 = *reinterpret_cast<const bf16x8*>(Qw + 176);
      const int pos = pos0 + wid * QBLK + r32; const float* cs = cosT + pos * 32 + hi * 8; const float* sn = sinT + pos * 32 + hi * 8;
      rope8(a0, b0, cs, sn, qr[8], qr[10]); rope8(a1, b1, cs + 16, sn + 16, qr[9], qr[11]); }
    const int wu = __builtin_amdgcn_readfirstlane(wid);
    unsigned koff[2], vofs[2], roff;
#pragma unroll
    for (int i = 0; i < 2; ++i) { const int ch = (2 * wid + i) * 64 + lane;
        { const int row = ch >> 4, c = (ch & 15) ^ (row & 15); koff[i] = (unsigned)(row * LDK * 2 + c * 16); }
        { const int sub = ch >> 5, kk = ((sub >> 2) << 3) + ((ch & 31) >> 2), c = ((sub & 3) << 5) + ((ch & 3) << 3), k = (kk & ~0xC) | ((kk & 4) << 1) | ((kk & 8) >> 1);
          vofs[i] = (unsigned)(k * LDK * 2 + c * 2); } }
    { const int ch = wid * 64 + lane, row = ch >> 3, c = (ch & 7) ^ ((row >> 1) & 7); roff = (unsigned)(row * LDKR * 2 + c * 16); }
    const int vb0 = (int)V_lds + v_rd_base(lane);
    const __amdgpu_buffer_rsrc_t srdK = __builtin_amdgcn_make_buffer_rsrc((void*)Kh, (short)0, (int)(SEQ * LDK * 2 - 256), 0x00020000);
    const __amdgpu_buffer_rsrc_t srdV = __builtin_amdgcn_make_buffer_rsrc((void*)Vh, (short)0, (int)(SEQ * LDK * 2 - 256), 0x00020000);
    const __amdgpu_buffer_rsrc_t srdR = __builtin_amdgcn_make_buffer_rsrc((void*)Kr, (short)0, (int)(SEQ * LDKR * 2), 0x00020000);
#define DMA(b, k0) do { const unsigned so_ = (unsigned)(k0) * (LDK * 2), sr_ = (unsigned)(k0) * (LDKR * 2); \
    _Pragma("unroll") for (int _i = 0; _i < 2; ++_i) { \
        __builtin_amdgcn_raw_ptr_buffer_load_lds(srdK, LDSP(unsigned, K_lds + (b) * SHM_K + (2 * wu + _i) * 1024), 16, koff[_i], so_, 0, 0); \
        __builtin_amdgcn_raw_ptr_buffer_load_lds(srdV, LDSP(unsigned, V_lds + (b) * SHM_V + (2 * wu + _i) * 1024), 16, vofs[_i], so_, 0, 0); } \
    __builtin_amdgcn_raw_ptr_buffer_load_lds(srdR, LDSP(unsigned, KR_lds + (b) * SHM_KR + wu * 1024), 16, roff, sr_, 0, 0); } while (0)
#define DMAWAIT() asm volatile("s_waitcnt vmcnt(0)" ::: "memory")
#define RESC(a) do { if (__any((a) < 1.f)) { if (hi == 0) al_l[r32] = (a); asm volatile("s_waitcnt lgkmcnt(0)" ::: "memory"); \
    _Pragma("unroll") for (int d = 0; d < 4; ++d) _Pragma("unroll") for (int r = 0; r < 16; ++r) o[d][r] *= al_l[crow(r, hi)]; } } while (0)
    f32x16 pA0, pA1, pB0, pB1; float alA, alB; bf16x8 pa0, pa1, pa2, pa3; const int NT = seq / KVBLK;
    static_assert(SDEPTH == 1, "ring form stages one tile ahead");
#define STEP(PX0, PX1, alX, PY0, PY1, alY, KB, VB, WB, K0NEXT, HASNEXT) do { \
        SBAR(); if (HASNEXT) DMA(WB, K0NEXT); SBAR(); \
        qkt(PX0, PX1, K_lds + (KB) * SHM_K, KR_lds + (KB) * SHM_KR, qr, QL, negm, r32, hi); \
        finishSM(PY0, PY1, alY, l_reg, pa0, pa1, pa2, pa3); SBAR(); \
        pv_d0(o, vb0 + (VB) * SHM_V, pa0, pa1, pa2, pa3); partialSM<false>(PX0, PX1, negm, alX); SBAR(); \
        RESC(alX); SBAR(); \
        DMAWAIT(); __syncthreads(); SBAR(); } while (0)
    __syncthreads();
    DMA(0, 0); DMA(1, KVBLK);
    asm volatile("s_waitcnt vmcnt(5)" ::: "memory"); __syncthreads();
    qkt(pA0, pA1, K_lds, KR_lds, qr, QL, negm, r32, hi); partialSM<true>(pA0, pA1, negm, alA);
    DMAWAIT(); __syncthreads();
    for (int j = 1; j + 6 <= NT - 1; j += 6) {
        STEP(pB0, pB1, alB, pA0, pA1, alA, 1, 0, 2, (j + 1) * KVBLK, true);
        STEP(pA0, pA1, alA, pB0, pB1, alB, 2, 1, 0, (j + 2) * KVBLK, true);
        STEP(pB0, pB1, alB, pA0, pA1, alA, 0, 2, 1, (j + 3) * KVBLK, true);
        STEP(pA0, pA1, alA, pB0, pB1, alB, 1, 0, 2, (j + 4) * KVBLK, true);
        STEP(pB0, pB1, alB, pA0, pA1, alA, 2, 1, 0, (j + 5) * KVBLK, true);
        STEP(pA0, pA1, alA, pB0, pB1, alB, 0, 2, 1, (j + 6) * KVBLK, true);
    }
    STEP(pB0, pB1, alB, pA0, pA1, alA, 1, 0, 0, 0, false);
    finishSM(pB0, pB1, alB, l_reg, pa0, pa1, pa2, pa3); SBAR();
    pv_d0(o, vb0 + 1 * SHM_V, pa0, pa1, pa2, pa3);
#undef STEP
    {
      const int tid2 = tid_opaque(), wid2 = tid2 >> 6, r32e = tid2 & 31, hie = (tid2 >> 5) & 1;
      float* li2 = (float*)(lds + OFF_WS) + wid2 * 64;
      if (hie == 0) li2[r32e] = l_reg; asm volatile("s_waitcnt lgkmcnt(0)" ::: "memory");
      float rli[16];
#pragma unroll
      for (int r = 0; r < 16; ++r) rli[r] = __builtin_amdgcn_rcpf(li2[crow(r, hie)]);
      bf16_t* Ow = Ob + (size_t)(wid2 * QBLK) * LDO;
#pragma unroll
      for (int r = 0; r < 16; ++r) { int orow = crow(r, hie);
#pragma unroll
          for (int d0 = 0; d0 < 4; ++d0) Ow[(size_t)orow * LDO + d0 * 32 + r32e] = (bf16_t)f2bf(o[d0][r] * rli[r]); } }
#undef DMA
#undef DMAWAIT
#undef RESC
}
}

__device__ const double INVF[32] = {
    1.0, 0.7498942093324559, 0.5623413251903491, 0.4216965034285822, 0.31622776601683794, 0.23713737056616552, 0.1778279410038923, 0.1333521432163324,
    0.1, 0.07498942093324558, 0.05623413251903491, 0.042169650342858224, 0.03162277660168379, 0.023713737056616554, 0.01778279410038923, 0.01333521432163324,
    0.01, 0.007498942093324558, 0.005623413251903491, 0.004216965034285823, 0.0031622776601683794, 0.0023713737056616554, 0.0017782794100389228, 0.001333521432163324,
    0.001, 0.0007498942093324559, 0.0005623413251903491, 0.00042169650342858224, 0.00031622776601683794, 0.00023713737056616554, 0.00017782794100389227, 0.0001333521432163324};

struct Params { const float* in[24]; float* out; unsigned char* ws; };

__device__ __forceinline__ void tables_phase(float* cosT, float* sinT) {
    for (int i = blockIdx.x * NTHREADS + tid_opaque(); i < SEQ * 32; i += gridDim.x * NTHREADS) {
        const int pos = i >> 5, j = i & 31;
        const double rev = (double)pos * INVF[j] * 0.15915494309189535;
        const float fr = (float)(rev - __builtin_rint(rev));
        cosT[i] = __builtin_amdgcn_cosf(fr); sinT[i] = __builtin_amdgcn_sinf(fr);
    }
}
__device__ __forceinline__ void mod_phase(const Params& p, float* mod, float* lds) {
    const int tid = tid_opaque(), kg = tid >> 7, col = tid & 127;
    float* sc = lds;
    float* red = lds + 6 * 1024;
    const float* cp = p.in[2]; const float* csmp = p.in[3];
    for (int i = tid; i < 6 * 1024; i += NTHREADS) { const int b = i >> 10, k = i & 1023; const float c = b < 4 ? cp[b * 1024 + k] : csmp[(b - 4) * 1024 + k]; sc[i] = c * sigmoidf_(c); }
    __syncthreads();
    const int nitem = DEPTH * (NMOD * DM / 128);
    for (int it = blockIdx.x; it < nitem; it += gridDim.x) {
        const int l = it / 72, n0 = (it % 72) * 128;
        const float* w = p.in[4] + (size_t)l * DM * (NMOD * DM) + n0 + col;
        float a0 = 0, a1 = 0, a2 = 0, a3 = 0, a4 = 0, a5 = 0;
#pragma unroll 16
        for (int k = kg * 256; k < kg * 256 + 256; ++k) { const float wv = __builtin_nontemporal_load(w + (size_t)k * (NMOD * DM));
            a0 += sc[k] * wv; a1 += sc[1024 + k] * wv; a2 += sc[2048 + k] * wv; a3 += sc[3072 + k] * wv; a4 += sc[4096 + k] * wv; a5 += sc[5120 + k] * wv; }
        float* rr = red + (kg * 6) * 128 + col;
        rr[0] = a0; rr[128] = a1; rr[256] = a2; rr[384] = a3; rr[512] = a4; rr[640] = a5;
        __syncthreads();
        for (int i = tid; i < 6 * 128; i += NTHREADS) { const int b = i >> 7, c = i & 127;
            const float s = red[(0 * 6 + b) * 128 + c] + red[(1 * 6 + b) * 128 + c] + red[(2 * 6 + b) * 128 + c] + red[(3 * 6 + b) * 128 + c];
            mod[((size_t)(l * NSEQ + b)) * (NMOD * DM) + n0 + c] = s + p.in[5][(size_t)l * (NMOD * DM) + n0 + c]; }
        __syncthreads();
    }
}

struct WDesc { const float* src; bf16_t* dst; int ldsrc, kvalid, kdst, ndst, mode, base0, base1, nvalid; };
__device__ __forceinline__ void cvt_one(const WDesc d, float* tile) {
    const int tid = tid_opaque();
    const int ntk = d.kdst >> 6, ntn = d.ndst >> 6, nt = ntk * ntn;
    for (int t = blockIdx.x; t < nt; t += gridDim.x) {
        const int n0 = (t / ntk) * 64, k0 = (t % ntk) * 64;
        int sc;
        if (d.mode == 0) sc = n0 < d.nvalid ? d.base0 + n0 : -1;
        else { const int pn = n0 >> 8, i = n0 & 255; sc = (i < 128 ? d.base0 : d.base1) + 128 * pn + (i & 127); }
        const bool valid = sc >= 0 && k0 < d.kvalid;
        __syncthreads();
        if (valid) {
#pragma unroll
            for (int i = 0; i < 2; ++i) { const int e = tid + i * 512, kk = e >> 4, j4 = (e & 15) * 4;
                const f32x4 v = __builtin_nontemporal_load((const f32x4*)(d.src + (size_t)(k0 + kk) * d.ldsrc + sc + j4));
                float* tp = tile + kk * 65 + j4; tp[0] = v[0]; tp[1] = v[1]; tp[2] = v[2]; tp[3] = v[3]; }
        }
        __syncthreads();
        const int j = tid >> 3, kc = (tid & 7) * 8;
        u32x4 w = {0u, 0u, 0u, 0u};
        if (valid) { const float* tp = tile + kc * 65 + j;
            w.x = pk2(tp[0], tp[65]); w.y = pk2(tp[130], tp[195]); w.z = pk2(tp[260], tp[325]); w.w = pk2(tp[390], tp[455]); }
        *(u32x4*)(d.dst + (size_t)(n0 + j) * d.kdst + k0 + kc) = w;
    }
}
__device__ __forceinline__ void cvt_phase(const Params& p, int l, bf16_t* W, float* tile) {
#pragma nounroll
    for (int wi = 0; wi < 13; ++wi) {
        WDesc d;
        switch (wi) {
        case 0: d = WDesc{p.in[7] + (size_t)l * DM * 2 * DFF, W + WO_1GU, 2 * DFF, DM, DM, 2 * DFF, 1, 0, DFF, 0}; break;
        case 1: d = WDesc{p.in[8] + (size_t)l * DFF * DM, W + WO_1DN, DM, DFF, DFF, DM, 0, 0, 0, DM}; break;
        case 2: d = WDesc{p.in[11] + (size_t)l * DM * INW, W + WO_INA, INW, DM, DM, ZSW, 0, 0, 0, O4}; break;
        case 3: d = WDesc{p.in[11] + (size_t)l * DM * INW, W + WO_ING, INW, DM, DM, 2048, 1, O4, O4 + 1024, 0}; break;
        case 4: d = WDesc{p.in[13] + (size_t)l * QLR * 1536, W + WO_QB, 1536, QLR, 256, 1536, 0, 0, 0, 1536}; break;
        case 5: d = WDesc{p.in[15] + (size_t)l * KVLR * 2048, W + WO_KVB, 2048, KVLR, 256, 2048, 0, 0, 0, 2048}; break;
        case 6: case 7: case 8: case 9: { const int g = wi - 6;
            d = WDesc{p.in[16] + ((size_t)l * 4 + g) * 256 * 256, W + WO_POOL + (size_t)g * 256 * 256, 256, 256, 256, 256, 0, 0, 0, 256}; break; }
        case 10: d = WDesc{p.in[18] + (size_t)l * DM * DM, W + WO_OUT, DM, DM, DM, DM, 0, 0, 0, DM}; break;
        case 11: d = WDesc{p.in[21] + (size_t)l * DM * 2 * DFF, W + WO_2GU, 2 * DFF, DM, DM, 2 * DFF, 1, 0, DFF, 0}; break;
        default: d = WDesc{p.in[22] + (size_t)l * DFF * DM, W + WO_2DN, DM, DFF, DFF, DM, 0, 0, 0, DM}; break;
        }
        cvt_one(d, tile);
    }
}

struct RowArgs { const float* xp; const float* xs; float* xout; const bf16_t* y; const float* post; const float* gate; float gfac; const float* pre; const float* shift; const float* scale; bf16_t* h; };
__device__ __forceinline__ void row_phase(const float* a_xp, const float* a_xs, float* a_xout, const bf16_t* a_y, const float* a_post, const float* a_gate, const float a_gfac, const float* a_pre, const float* a_shift, const float* a_scale, bf16_t* a_h, const bool a_wx) {
    constexpr int RG = 4;
    const int tid = tid_opaque(), wid = tid >> 6, lane = tid & 63;
    for (int g = blockIdx.x * 8 + wid; g < NTOK / RG; g += gridDim.x * 8) {
        const int r0 = g * RG, b = r0 >> 13;
        f32x4 x[RG][4]; u32x2 yw[RG][4];
#pragma unroll
        for (int q = 0; q < RG; ++q) { const int r = r0 + q;
            const float* xin = a_xp ? (r < NPROMPT_TOK ? a_xp + (size_t)r * DM : a_xs + (size_t)(r - NPROMPT_TOK) * DM) : a_xout + (size_t)r * DM;
#pragma unroll
            for (int i = 0; i < 4; ++i) x[q][i] = __builtin_nontemporal_load((const f32x4*)(xin + i * 256 + lane * 4));
            if (a_y) {
#pragma unroll
                for (int i = 0; i < 4; ++i) yw[q][i] = __builtin_nontemporal_load((const u32x2*)(a_y + (size_t)r * DM + i * 256 + lane * 4)); } }
        if (a_y) {
            f32x4 pg[4], gv[4];
            const float* gt = a_gate + (size_t)b * (NMOD * DM);
#pragma unroll
            for (int i = 0; i < 4; ++i) { pg[i] = *(const f32x4*)(a_post + i * 256 + lane * 4); gv[i] = *(const f32x4*)(gt + i * 256 + lane * 4); pg[i] = pg[i] * gv[i] * a_gfac; }
#pragma unroll
            for (int q = 0; q < RG; ++q) {
                f32x4 yv[4]; float ss = 0;
#pragma unroll
                for (int i = 0; i < 4; ++i) { const u32x2 w = yw[q][i];
                    yv[i] = (f32x4){__builtin_bit_cast(float, w.x << 16), __builtin_bit_cast(float, w.x & 0xffff0000u), __builtin_bit_cast(float, w.y << 16), __builtin_bit_cast(float, w.y & 0xffff0000u)};
                    ss += yv[i][0] * yv[i][0] + yv[i][1] * yv[i][1] + yv[i][2] * yv[i][2] + yv[i][3] * yv[i][3]; }
                ss = wave_sum(ss, lane);
                const float rs = __builtin_amdgcn_rsqf(ss * (1.f / DM) + EPS);
#pragma unroll
                for (int i = 0; i < 4; ++i) x[q][i] += pg[i] * (yv[i] * rs);
            }
        }
        if (a_wx) {
#pragma unroll
            for (int q = 0; q < RG; ++q)
#pragma unroll
                for (int i = 0; i < 4; ++i) __builtin_nontemporal_store(x[q][i], (f32x4*)(a_xout + (size_t)(r0 + q) * DM + i * 256 + lane * 4));
        }
        if (a_h) {
            const float* sh = a_shift + (size_t)b * (NMOD * DM); const float* scl = a_scale + (size_t)b * (NMOD * DM);
            f32x4 pg[4], sv[4];
#pragma unroll
            for (int i = 0; i < 4; ++i) { pg[i] = *(const f32x4*)(a_pre + i * 256 + lane * 4); sv[i] = *(const f32x4*)(sh + i * 256 + lane * 4); const f32x4 cv = *(const f32x4*)(scl + i * 256 + lane * 4); pg[i] = pg[i] * (cv + 1.f); }
#pragma unroll
            for (int q = 0; q < RG; ++q) {
                float ss = 0;
#pragma unroll
                for (int i = 0; i < 4; ++i) ss += x[q][i][0] * x[q][i][0] + x[q][i][1] * x[q][i][1] + x[q][i][2] * x[q][i][2] + x[q][i][3] * x[q][i][3];
                ss = wave_sum(ss, lane);
                const float rs = __builtin_amdgcn_rsqf(ss * (1.f / DM) + EPS);
#pragma unroll
                for (int i = 0; i < 4; ++i) { const f32x4 hv = (x[q][i] * rs) * pg[i] + sv[i];
                    u32x2 w; w.x = cvtpk(hv[0], hv[1]); w.y = cvtpk(hv[2], hv[3]);
                    *(u32x2*)(a_h + (size_t)(r0 + q) * DM + i * 256 + lane * 4) = w; }
            }
        }
    }
}

template <int GP> __device__ __forceinline__ void pool_group(const bf16_t* zs, bf16_t* pooled, int r, int t, int lane) {
    constexpr int half = 1 << GP, NW2 = 2 * half;
    const int lo = t - half < 0 ? 0 : t - half, hi = t + half > SEQ ? SEQ : t + half;
    const bf16_t* ub = zs + (size_t)(r - t) * ZSW + 448 + GP * 256 + lane * 4;
    u32x2 wv[NW2];
#pragma unroll
    for (int j = 0; j < NW2; ++j) { int tt = t - half + j; tt = tt < 0 ? 0 : (tt > SEQ - 1 ? SEQ - 1 : tt); wv[j] = *(const u32x2*)(ub + (size_t)tt * ZSW); }
    float s0 = 0, s1 = 0, s2 = 0, s3 = 0;
#pragma unroll
    for (int j = 0; j < NW2; ++j) { const int tt = t - half + j; const bool ok = tt >= 0 && tt < SEQ; const u32x2 w = wv[j];
        s0 += ok ? __builtin_bit_cast(float, w.x << 16) : 0.f; s1 += ok ? __builtin_bit_cast(float, w.x & 0xffff0000u) : 0.f;
        s2 += ok ? __builtin_bit_cast(float, w.y << 16) : 0.f; s3 += ok ? __builtin_bit_cast(float, w.y & 0xffff0000u) : 0.f; }
    const float inv = 1.f / (float)(hi - lo);
    const u32x2 w = wv[half];
    const float u0 = __builtin_bit_cast(float, w.x << 16), u1 = __builtin_bit_cast(float, w.x & 0xffff0000u), u2 = __builtin_bit_cast(float, w.y << 16), u3 = __builtin_bit_cast(float, w.y & 0xffff0000u);
    u32x2 o; o.x = cvtpk(s0 * inv - u0, s1 * inv - u1); o.y = cvtpk(s2 * inv - u2, s3 * inv - u3);
    *(u32x2*)(pooled + (size_t)r * DM + GP * 256 + lane * 4) = o;
}
__device__ __forceinline__ void prep_phase(const bf16_t* zs, bf16_t* qn, bf16_t* kvn, bf16_t* krope, bf16_t* pooled, const float* qg, const float* kvg, const float* cosT, const float* sinT) {
    const int tid = tid_opaque(), wid = tid >> 6, lane = tid & 63;
#pragma unroll 2
    for (int r = blockIdx.x * 8 + wid; r < CTOK; r += gridDim.x * 8) {
        const int t = r & (SEQ - 1);
        const bf16_t* z = zs + (size_t)r * ZSW;
        { const u32x2 w = *(const u32x2*)(z + lane * 4);
          const float v0 = __builtin_bit_cast(float, w.x << 16), v1 = __builtin_bit_cast(float, w.x & 0xffff0000u), v2 = __builtin_bit_cast(float, w.y << 16), v3 = __builtin_bit_cast(float, w.y & 0xffff0000u);
          const float ss = wave_sum(v0 * v0 + v1 * v1 + v2 * v2 + v3 * v3, lane);
          const float rs = __builtin_amdgcn_rsqf(ss * (1.f / QLR) + EPS);
          const f32x4 g = *(const f32x4*)(qg + lane * 4);
          u32x2 o; o.x = cvtpk(v0 * rs * g[0], v1 * rs * g[1]); o.y = cvtpk(v2 * rs * g[2], v3 * rs * g[3]);
          *(u32x2*)(qn + (size_t)r * 256 + lane * 4) = o; }
        { const unsigned w = *(const unsigned*)(z + QLR + lane * 2);
          const float v0 = __builtin_bit_cast(float, w << 16), v1 = __builtin_bit_cast(float, w & 0xffff0000u);
          const float ss = wave_sum(v0 * v0 + v1 * v1, lane);
          const float rs = __builtin_amdgcn_rsqf(ss * (1.f / KVLR) + EPS);
          *(unsigned*)(kvn + (size_t)r * 256 + lane * 2) = cvtpk(v0 * rs * kvg[lane * 2], v1 * rs * kvg[lane * 2 + 1]);
          *(unsigned*)(kvn + (size_t)r * 256 + 128 + lane * 2) = 0u; }
        { const float kr = bf2f(z[QLR + KVLR + lane]); const float pr = shfl_xor_l(kr, 32, lane);
          const int j = lane & 31; const float c = cosT[t * 32 + j], s = sinT[t * 32 + j];
          const float o = lane < 32 ? kr * c - pr * s : kr * c + pr * s;
          krope[(size_t)r * 64 + lane] = (bf16_t)f2bf(o); }
        pool_group<0>(zs, pooled, r, t, lane); pool_group<1>(zs, pooled, r, t, lane); pool_group<2>(zs, pooled, r, t, lane); pool_group<3>(zs, pooled, r, t, lane);
    }
}

__device__ __forceinline__ void attn_phase(const bf16_t* q, const bf16_t* kv, const bf16_t* krope, bf16_t* oa, const float* cosT, const float* sinT, char* lds) {
    const int G = gridDim.x, bid = blockIdx.x;
    constexpr int NPAIR = CSEQ * NHEAD, NQB = SEQ / 256, NUNIT = NPAIR * NQB;
    for (int i = 0;; ++i) {
        int pair, qb;
        if ((G & 7) == 0) { const int xcd = bid & 7, slot = bid >> 3, j = i * (G >> 3) + slot; pair = (j / NQB) * 8 + xcd; qb = j % NQB; if (pair >= NPAIR) break; }
        else { const int u = i * G + bid; if (u >= NUNIT) break; pair = u / NQB; qb = u % NQB; }
        const int s = pair / NHEAD, h = pair % NHEAD;
        const size_t row0 = (size_t)s * SEQ + (size_t)qb * 256, key0 = (size_t)s * SEQ;
        att::attn_unit(q + row0 * 1536 + h * 192, kv + key0 * 2048 + h * 256, kv + key0 * 2048 + h * 256 + 128, krope + key0 * 64,
                       oa + row0 * 1024 + h * 128, cosT, sinT, qb * 256, SEQ, lds);
    }
}

constexpr int STEPS = 4 + 5 * NCHUNK + 4;

__global__ void __launch_bounds__(NTHREADS, 2) fwd_megakernel(Params p) {
    extern __shared__ __attribute__((aligned(16))) unsigned char lds[];
    cg::grid_group grid = cg::this_grid();
    unsigned char* ws = p.ws;
    float* mod = (float*)(ws + WS_MOD); float* cosT = (float*)(ws + WS_COS); float* sinT = (float*)(ws + WS_SIN);
    bf16_t* W = (bf16_t*)(ws + WS_W); bf16_t* H = (bf16_t*)(ws + WS_H); bf16_t* Y = (bf16_t*)(ws + WS_Y);
    unsigned char* big = ws + WS_BIG; bf16_t* ACT = (bf16_t*)big;
    bf16_t* ZS = (bf16_t*)(ws + WS_ZS); bf16_t* MG = (bf16_t*)(big + MX_ZS); bf16_t* QN = (bf16_t*)(big + MX_QN); bf16_t* KVN = (bf16_t*)(big + MX_KVN); bf16_t* KR = (bf16_t*)(big + MX_KR);
    bf16_t* PL = (bf16_t*)(big + MX_PL); bf16_t* Q = (bf16_t*)(big + MX_Q); bf16_t* KV = (bf16_t*)(big + MX_KV); bf16_t* OA = (bf16_t*)(big + MX_OA); bf16_t* OP = (bf16_t*)(big + MX_OP);
    PG8_LAS unsigned char* ldsl = (PG8_LAS unsigned char*)lds;
    const int G = gridDim.x, bid = blockIdx.x;

    volatile LAS unsigned* misc = (volatile LAS unsigned*)((LAS unsigned char*)lds + LDS_MISC);
    if (threadIdx.x < 4) misc[threadIdx.x] = 0u;
    __syncthreads();
    const XcdBarrier bar = xcd_barrier_post((unsigned*)(ws + WS_BAR), misc);
    tables_phase(cosT, sinT);
    mod_phase(p, mod, (float*)lds);
    cvt_phase(p, 0, W, (float*)lds);
    grid.sync();

#pragma nounroll
    for (int ph = -1; ph < DEPTH * STEPS; ++ph) {
        const int l = ph < 0 ? 0 : ph / STEPS, s = ph < 0 ? -1 : ph % STEPS;
        const float* modl = mod + (size_t)l * NSEQ * NMOD * DM;
        int kind;
        int c = 0, k = 0;
        if (s < 0 || s == 2 || s == STEPS - 4 || s == STEPS - 1) kind = 0;
        else if (s == 0 || s == STEPS - 3) kind = 1;
        else if (s == 1 || s == STEPS - 2) kind = 2;
        else if (s == 3) { k = 0; kind = 2; }
        else { c = (s - 4) / 5; k = (s - 4) % 5 + 1; kind = k == 1 ? 3 : k == 2 ? 2 : k == 3 ? 4 : k == 4 ? 5 : 2; }
        const size_t crow0 = (size_t)c * CTOK;

        if (kind == 0) {
            const float* r_xp = nullptr; const float* r_xs = nullptr; const bf16_t* r_y = Y; const float* r_post; const float* r_gate; float r_gfac = 0.5f; const float* r_pre; const float* r_shift; const float* r_scale; bf16_t* r_h = H;
            if (s < 0) { r_xp = p.in[0]; r_xs = p.in[1]; r_y = nullptr; r_post = nullptr; r_gate = nullptr; r_pre = p.in[6]; r_shift = modl + 0 * DM; r_scale = modl + 1 * DM; }
            else if (s == 2) { if (l == 0) { r_xp = p.in[0]; r_xs = p.in[1]; } r_post = p.in[9] + l * DM; r_gate = modl + 2 * DM; r_pre = p.in[10] + l * DM; r_shift = modl + 3 * DM; r_scale = modl + 4 * DM; }
            else if (s == STEPS - 4) { r_post = p.in[19] + l * DM; r_gate = modl + 5 * DM; r_gfac = 1.f; r_pre = p.in[20] + l * DM; r_shift = modl + 6 * DM; r_scale = modl + 7 * DM; }
            else { const bool more = l + 1 < DEPTH; const float* modn = modl + (size_t)NSEQ * NMOD * DM;
                r_post = p.in[23] + l * DM; r_gate = modl + 8 * DM; r_pre = more ? p.in[6] + (l + 1) * DM : nullptr; r_shift = modn + 0 * DM; r_scale = modn + 1 * DM; r_h = more ? H : nullptr; }
            row_phase(r_xp, r_xs, p.out, r_y, r_post, r_gate, r_gfac, r_pre, r_shift, r_scale, r_h, s >= 0);
            if (s == STEPS - 1 && l + 1 < DEPTH) cvt_phase(p, l + 1, W, (float*)lds);
        } else if (kind == 1) {
            const bool second = s != 0;
            pg8::Gemm g{H, W + (second ? WO_2GU : WO_1GU), NTOK, 2 * DFF, DM, DM, DM, 0};
            pg8::StaticOrder S; S.init(NTOK, 2 * DFF, G, bid);
            pg8::Epi<1> E{ACT, DFF, nullptr, nullptr, nullptr, 1.f};
            pg8::gemm_phase(ldsl, g, S, E);
        } else if (kind == 2) {
            const int ng = (s >= 4 && s < STEPS - 4 && k == 2) ? 3 : 1;
#pragma nounroll
            for (int gi = 0; gi < ng; ++gi) {
                pg8::Gemm g; pg8::Epi<0> E;
                if (s == 1 || s == STEPS - 2) { g = pg8::Gemm{ACT, W + (s == 1 ? WO_1DN : WO_2DN), NTOK, DM, DFF, DFF, DFF, 0}; E = pg8::Epi<0>{Y, DM, nullptr, nullptr, nullptr, 1.f}; }
                else if (k == 0) { g = pg8::Gemm{H, W + WO_INA, NTOK, ZSW, DM, DM, DM, 0}; E = pg8::Epi<0>{ZS, ZSW, nullptr, nullptr, nullptr, 1.f}; }
                else if (k == 5) { g = pg8::Gemm{MG, W + WO_OUT, CTOK, DM, DM, DM, DM, 0}; E = pg8::Epi<0>{Y + crow0 * DM, DM, nullptr, nullptr, nullptr, 1.f}; }
                else if (gi == 0) { g = pg8::Gemm{KVN, W + WO_KVB, CTOK, 2048, 128, 256, 256, 0};     E = pg8::Epi<0>{KV, 2048, nullptr, nullptr, nullptr, 1.f}; }
                else if (gi == 1) { g = pg8::Gemm{QN, W + WO_QB, CTOK, 1536, 256, 256, 256, 0}; E = pg8::Epi<0>{Q, 1536, nullptr, nullptr, nullptr, att::QSCALE}; }
                else { g = pg8::Gemm{PL, W + WO_POOL, CTOK, DM, 256, DM, 256, 256}; E = pg8::Epi<0>{OP, DM, p.in[17] + l * DM, nullptr, nullptr, 1.f}; }
                pg8::StaticOrder S; S.init(g.M, g.N, G, bid);
                pg8::gemm_phase(ldsl, g, S, E);
            }
        } else if (kind == 3) {
            prep_phase(ZS + crow0 * ZSW, QN, KVN, KR, PL, p.in[12] + l * QLR, p.in[14] + l * KVLR, cosT, sinT);
        } else if (kind == 4) {
            attn_phase(Q, KV, KR, OA, cosT, sinT, (char*)lds);
        } else {
            pg8::Gemm g{H + crow0 * DM, W + WO_ING, CTOK, 2048, DM, DM, DM, 0};
            pg8::StaticOrder S; S.init(CTOK, 2048, G, bid);
            pg8::Epi<2> E{MG, DM, nullptr, OA, OP, 1.f};
            pg8::gemm_phase(ldsl, g, S, E);
        }
        if (ph + 1 < DEPTH * STEPS) xcd_barrier(bar);
    }
}

extern "C" void kernel_launch(void* const* d_in, const int* in_sizes, int n_in, void* d_out, int out_size, void* d_ws, size_t ws_size, hipStream_t stream) {
    static int grid = 0;
    if (grid == 0) {
        if (n_in != 24 || out_size != NTOK * DM || ws_size < WS_END) { fprintf(stderr, "kernel_launch: unexpected shapes: n_in %d out %d ws %zu (need %zu)\n", n_in, out_size, ws_size, (size_t)WS_END); grid = -1; return; }
        int dev = 0, cus = 0, per_cu = 0;
        hipGetDevice(&dev); hipDeviceGetAttribute(&cus, hipDeviceAttributeMultiprocessorCount, dev);
        if (hipFuncSetAttribute((const void*)fwd_megakernel, hipFuncAttributeMaxDynamicSharedMemorySize, LDS_BYTES) != hipSuccess) { fprintf(stderr, "kernel_launch: hipFuncSetAttribute failed\n"); grid = -1; return; }
        if (hipOccupancyMaxActiveBlocksPerMultiprocessor(&per_cu, (const void*)fwd_megakernel, NTHREADS, LDS_BYTES) != hipSuccess || per_cu < 1) { fprintf(stderr, "kernel_launch: occupancy query says %d blocks/CU\n", per_cu); per_cu = 1; }
        (void)hipGetLastError();
        grid = cus * (per_cu > 1 ? 1 : per_cu);
    }
    if (grid < 0) return;
    if (hipMemsetAsync((char*)d_ws + WS_BAR, 0, BAR_BYTES, stream) != hipSuccess) { fprintf(stderr, "kernel_launch: memset of barrier words failed\n"); return; }
    Params p{};
    for (int i = 0; i < 24; ++i) p.in[i] = (const float*)d_in[i];
    p.out = (float*)d_out; p.ws = (unsigned char*)d_ws;
    void* args[] = {&p};
    hipError_t e = hipLaunchCooperativeKernel((const void*)fwd_megakernel, dim3(grid), dim3(NTHREADS), args, LDS_BYTES, stream);
    if (e != hipSuccess) fprintf(stderr, "cooperative launch failed: %s (grid %d)\n", hipGetErrorString(e), grid);
}
```

```cpp
#include <hip/hip_runtime.h>
#include <hip/hip_cooperative_groups.h>
#include <cstdio>
#include <cstdint>
namespace cg = cooperative_groups;

constexpr int DM = 1024, SEQ = 8192, NSEQ = 6, NTOK = NSEQ * SEQ, DEPTH = 4, DFF = 2816, NMOD = 9;
constexpr int NPROMPT_TOK = 4 * SEQ;
constexpr int NHEAD = 8, QLR = 256, KVLR = 128, ROPE = 64;
constexpr int INW = 3520, ZSW = 1536  , O4 = 1472;
constexpr int NCHUNK = 3, CSEQ = NSEQ / NCHUNK, CTOK = CSEQ * SEQ;
constexpr float EPS = 1e-6f;
constexpr int NTHREADS = 512;
constexpr int LDS_MISC = 157952;
constexpr int LDS_BYTES = 158720;

typedef unsigned short bf16_t;
typedef short bf16x8 __attribute__((ext_vector_type(8)));
typedef short s16x4 __attribute__((ext_vector_type(4)));
typedef float f32x4 __attribute__((ext_vector_type(4)));
typedef float f32x16 __attribute__((ext_vector_type(16)));
typedef unsigned u32x4 __attribute__((ext_vector_type(4)));
typedef unsigned u32x2 __attribute__((ext_vector_type(2)));

constexpr size_t MiB = 1u << 20;
constexpr size_t WS_MOD = 0;
constexpr size_t WS_COS = 1 * MiB;
constexpr size_t WS_SIN = 2 * MiB;
constexpr size_t WS_BAR = 3 * MiB, BAR_BYTES = 16384;
constexpr size_t WS_W = 4 * MiB;
constexpr size_t WS_H = 52 * MiB;
constexpr size_t WS_Y = 148 * MiB;
constexpr size_t WS_BIG = 244 * MiB;
constexpr size_t WS_ZS = WS_BIG + 280 * MiB;
constexpr size_t WS_END = WS_ZS + 144 * MiB;
constexpr size_t MX_ZS = 0;
constexpr size_t MX_QN = 48 * MiB;
constexpr size_t MX_KVN = 56 * MiB;
constexpr size_t MX_KR = 64 * MiB;
constexpr size_t MX_PL = 66 * MiB;
constexpr size_t MX_Q = 98 * MiB;
constexpr size_t MX_KV = 146 * MiB;
constexpr size_t MX_OA = 210 * MiB;
constexpr size_t MX_OP = 242 * MiB;
static_assert(CTOK == 16384, "mixer buffer map assumes 16384-token chunks");
constexpr size_t WO_1GU = 0, WO_1DN = WO_1GU + (size_t)2 * DFF * DM, WO_INA = WO_1DN + (size_t)DM * DFF, WO_ING = WO_INA + (size_t)ZSW * DM,
                 WO_QB = WO_ING + (size_t)2048 * DM, WO_KVB = WO_QB + (size_t)1536 * 256, WO_POOL = WO_KVB + (size_t)2048 * 256,
                 WO_OUT = WO_POOL + (size_t)1024 * 256, WO_2GU = WO_OUT + (size_t)DM * DM, WO_2DN = WO_2GU + (size_t)2 * DFF * DM,
                 WO_END = WO_2DN + (size_t)DM * DFF;
static_assert(WO_END * 2 <= 48 * MiB, "weights fit");

__device__ __forceinline__ float bf2f(unsigned short h) { return __builtin_bit_cast(float, (unsigned)h << 16); }
__device__ __forceinline__ unsigned f2bf(float f) { unsigned u = __builtin_bit_cast(unsigned, f); return (u + 0x7fffu + ((u >> 16) & 1u)) >> 16; }
__device__ __forceinline__ unsigned pk2(float lo, float hi) { return f2bf(lo) | (f2bf(hi) << 16); }
typedef float f32x2_t __attribute__((ext_vector_type(2)));
typedef __bf16 bf16x2_t __attribute__((ext_vector_type(2)));
__device__ __forceinline__ unsigned cvtpk(float lo, float hi) { f32x2_t v = {lo, hi}; bf16x2_t b = __builtin_convertvector(v, bf16x2_t); return __builtin_bit_cast(unsigned, b); }
__device__ __forceinline__ float sigmoidf_(float x) { return __builtin_amdgcn_rcpf(1.f + __builtin_amdgcn_exp2f(-x * 1.4426950408889634f)); }
__device__ __forceinline__ int tid_opaque() { int t = threadIdx.x; asm volatile("" : "+v"(t)); return t; }
__device__ __forceinline__ float shfl_xor_l(float v, int o, int lane) { return __builtin_bit_cast(float, __builtin_amdgcn_ds_bpermute((lane ^ o) << 2, __builtin_bit_cast(int, v))); }
__device__ __forceinline__ float wave_sum(float v, int lane) {
#pragma unroll
    for (int o = 32; o >= 1; o >>= 1) v += shfl_xor_l(v, o, lane);
    return v;
}

#define XB_TMO      128
#define XB_XCNT(j)  (256  + 64 * (j))
#define XB_XSUB(j)  (1280 + 64 * (j))
#define XB_XGEN(j)  (2304 + 64 * (j))
#define XB_TOP      3328
#define XB_TOPGEN   3392
#define XCD_BAR_WORDS 3456
#define XB_SPIN_CAP (1u << 22)
#define LAS __attribute__((address_space(3)))
__device__ __forceinline__ unsigned xb_ld(unsigned* p)              { return __hip_atomic_load(p, __ATOMIC_RELAXED, __HIP_MEMORY_SCOPE_AGENT); }
__device__ __forceinline__ unsigned xb_add(unsigned* p, unsigned v) { return __hip_atomic_fetch_add(p, v, __ATOMIC_RELAXED, __HIP_MEMORY_SCOPE_AGENT); }
__device__ __forceinline__ unsigned xb_xcc_id() { return (unsigned)__builtin_amdgcn_s_getreg((3 << 11) | 20) & 0xFu; }
#define XB_SPIN(cond, bar) do { unsigned _sp = 0; while (cond) { __builtin_amdgcn_s_sleep(1); \
    if ((++_sp & 255u) == 0u) { if (xb_ld(&(bar)[XB_TMO])) break; if (_sp > XB_SPIN_CAP) { atomicAdd(&(bar)[XB_TMO], 1u); break; } } } } while (0)
struct XcdBarrier { unsigned* bar; unsigned x; volatile LAS unsigned* st; };
__device__ __forceinline__ XcdBarrier xcd_barrier_post(unsigned* bar, volatile LAS unsigned* st) {
    XcdBarrier b; b.bar = bar; b.x = xb_xcc_id(); b.st = st;
    if (threadIdx.x == 0) (void)xb_add(&bar[XB_XCNT(b.x)], 1u);
    return b;
}
__device__ __forceinline__ void xcd_barrier_complete(unsigned* bar, unsigned x, unsigned& nloc, unsigned& nx) {
    const unsigned G = gridDim.x * gridDim.y * gridDim.z;
    unsigned sum, cnt, mine, sp = 0u;
    for (;;) {
        sum = 0u; cnt = 0u; mine = 0u;
#pragma unroll
        for (unsigned j = 0; j < 16; ++j) { const unsigned c = xb_ld(&bar[XB_XCNT(j)]); sum += c; cnt += (c > 0u) ? 1u : 0u; mine = (j == x) ? c : mine; }
        if (sum == G) break;
        __builtin_amdgcn_s_sleep(1);
        if ((++sp & 255u) == 0u) { if (xb_ld(&bar[XB_TMO])) break; if (sp > XB_SPIN_CAP) { atomicAdd(&bar[XB_TMO], 1u); break; } }
    }
    nloc = mine > 0u ? mine : 1u; nx = cnt > 0u ? cnt : 1u;
}
__device__ __forceinline__ void xcd_barrier(const XcdBarrier& b) {
    asm volatile("s_waitcnt vmcnt(0)" ::: "memory");
    __syncthreads();
    if (threadIdx.x == 0) {
        unsigned* bar = b.bar;
        __builtin_amdgcn_s_waitcnt(0);
        unsigned nloc = b.st[0], nx = b.st[1];
        if (nloc == 0u) { xcd_barrier_complete(bar, b.x, nloc, nx); b.st[0] = nloc; b.st[1] = nx; }
        const unsigned old = xb_add(&bar[XB_XSUB(b.x)], 1u);
        const unsigned gen = old / nloc;
        if (old + 1u == (gen + 1u) * nloc) {
            __builtin_amdgcn_fence(__ATOMIC_RELEASE, "agent");
            asm volatile("s_waitcnt vmcnt(0)" ::: "memory");
            const unsigned og = xb_add(&bar[XB_TOP], 1u);
            const unsigned tg = og / nx;
            if (og + 1u == (tg + 1u) * nx) xb_add(&bar[XB_TOPGEN], 1u);
            else XB_SPIN(xb_ld(&bar[XB_TOPGEN]) == tg, bar);
            __builtin_amdgcn_fence(__ATOMIC_ACQUIRE, "agent");
            xb_add(&bar[XB_XGEN(b.x)], 1u);
            asm volatile("s_waitcnt vmcnt(0)" ::: "memory");
        } else {
            XB_SPIN(xb_ld(&bar[XB_XGEN(b.x)]) == gen, bar);
            __builtin_amdgcn_fence(__ATOMIC_ACQUIRE, "agent");
            asm volatile("s_waitcnt vmcnt(0)" ::: "memory");
        }
    }
    __syncthreads();
}

namespace pg8 {
#define PG8_LAS __attribute__((address_space(3)))
constexpr int BM = 256, BK = 64, HALF = 128, HTB = HALF * BK * 2, STAGE_BYTES = 8 * HTB, NXCD = 8, WGM = 8;
__host__ __device__ __forceinline__ int lds_byte(int r, int c) { const int st = (r >> 4) * 2 + (c >> 5), rr = r & 15, cc = c & 31, ob = rr * 64 + cc * 2; return st * 1024 + (ob ^ (((ob >> 9) & 1) << 5)); }
__host__ __device__ __forceinline__ void stage_rc(int b, int& R, int& C) { const int st = b / 1024, sb = b % 1024, swz = sb ^ (((sb >> 9) & 1) << 5); R = (st >> 1) * 16 + swz / 64; C = (st & 1) * 32 + (swz % 64) / 2; }
__host__ __device__ __forceinline__ int perm32(int rho) { const int n = rho >> 4, i = rho & 15; return 8 * (i >> 2) + 4 * n + (i & 3); }
struct Unit { int pm, pn; };
struct Gemm { const bf16_t* A; const bf16_t* Bt; int M, N, K, lda, ldb, a_pn_off; };
struct StaticOrder {
    int nM, nN, nwg, G, c;
    __device__ void init(int M, int N, int G_, int c_) { nM = M / BM; nN = N / BM; nwg = nM * nN; G = G_; c = c_; }
    __device__ bool next(int i, Unit& u) const {
        const long L = (long)i * G + c; if (L >= nwg) return false;
        int wgid = (int)L; { const int q = nwg / NXCD, r = nwg % NXCD, xcd = wgid % NXCD, off = wgid / NXCD; wgid = (xcd < r ? xcd * (q + 1) : r * (q + 1) + (xcd - r) * q) + off; }
        const int nig = WGM * nN, gid = wgid / nig, fm = gid * WGM, gsz = (nM - fm) < WGM ? (nM - fm) : WGM;
        u.pm = fm + ((wgid % nig) % gsz); u.pn = (wgid % nig) / gsz; return true;
    }
};
template <int MODE> struct Epi {
    bf16_t* O; int ldc; const float* cs; const bf16_t* oa; const bf16_t* op; float sc;
    __device__ __forceinline__ void operator()(const f32x4 (&acc)[2][2][4][2], const Unit& u, int wr, int wc, int fr, int fq) const {
        const int row0 = u.pm * BM + wr * 64 + fr;
        if constexpr (MODE == 0) {
            const int col0 = u.pn * BM + wc * 32 + 8 * fq;
            f32x4 sv[2][2];
#pragma unroll
            for (int bj = 0; bj < 2; ++bj)
#pragma unroll
                for (int n = 0; n < 2; ++n) sv[bj][n] = (cs ? *(const f32x4*)(cs + col0 + bj * HALF + 4 * n) : (f32x4){1.f, 1.f, 1.f, 1.f}) * sc;
#pragma unroll
            for (int ai = 0; ai < 2; ++ai)
#pragma unroll
                for (int m = 0; m < 4; ++m) { bf16_t* rowp = O + (size_t)(row0 + ai * HALF + m * 16) * ldc + col0;
#pragma unroll
                    for (int bj = 0; bj < 2; ++bj) { const f32x4 v0 = acc[ai][bj][m][0] * sv[bj][0], v1 = acc[ai][bj][m][1] * sv[bj][1];
                        u32x4 w; w.x = cvtpk(v0[0], v0[1]); w.y = cvtpk(v0[2], v0[3]); w.z = cvtpk(v1[0], v1[1]); w.w = cvtpk(v1[2], v1[3]);
                        *(u32x4*)(rowp + bj * HALF) = w; } }
        } else {
            const int col0 = u.pn * HALF + wc * 32 + 8 * fq;
#pragma unroll
            for (int ai = 0; ai < 2; ++ai)
#pragma unroll
                for (int m = 0; m < 4; ++m) { const size_t ro = (size_t)(row0 + ai * HALF + m * 16) * ldc + col0;
                    float r[8];
                    if constexpr (MODE == 1) {
#pragma unroll
                        for (int n = 0; n < 2; ++n)
#pragma unroll
                            for (int j = 0; j < 4; ++j) { const float g = acc[ai][0][m][n][j], up = acc[ai][1][m][n][j]; r[n * 4 + j] = g * sigmoidf_(g) * up; }
                    } else {
                        const u32x4 a = *(const u32x4*)(oa + ro), b = *(const u32x4*)(op + ro);
#pragma unroll
                        for (int n = 0; n < 2; ++n)
#pragma unroll
                            for (int j = 0; j < 4; ++j) { const int e = n * 4 + j; const unsigned aw = a[e >> 1], bw = b[e >> 1];
                                const float av = (e & 1) ? __builtin_bit_cast(float, aw & 0xffff0000u) : __builtin_bit_cast(float, aw << 16);
                                const float bv = (e & 1) ? __builtin_bit_cast(float, bw & 0xffff0000u) : __builtin_bit_cast(float, bw << 16);
                                r[e] = sigmoidf_(acc[ai][0][m][n][j]) * av + sigmoidf_(acc[ai][1][m][n][j]) * bv; }
                    }
                    u32x4 w; w.x = cvtpk(r[0], r[1]); w.y = cvtpk(r[2], r[3]); w.z = cvtpk(r[4], r[5]); w.w = cvtpk(r[6], r[7]);
                    *(u32x4*)(O + ro) = w; }
        }
    }
};

template <class EpiT>
__device__ __forceinline__ void gemm_phase(PG8_LAS unsigned char* lds, const Gemm g, const StaticOrder& S, const EpiT& E) {
    const int tid = tid_opaque(), wid = __builtin_amdgcn_readfirstlane(tid >> 6), lane = tid & 63, wr = wid >> 2, wc = wid & 3, fr = lane & 15, fq = lane >> 4;
    const int K = g.K, nt = K / BK;
    const char* gA = (const char*)g.A; const char* gB = (const char*)g.Bt;
    asm volatile("" : "+s"(gA), "+s"(gB));
    unsigned voffA[2], voffB[2];
#pragma unroll
    for (int i = 0; i < 2; ++i) { int R, C; stage_rc(tid * 16 + i * 8192, R, C); const int Rb = (R & ~31) + perm32(R & 31);
        voffA[i] = (unsigned)(R * g.lda + C) * 2u; voffB[i] = (unsigned)(Rb * g.ldb + C) * 2u; }
    const __amdgpu_buffer_rsrc_t srdA = __builtin_amdgcn_make_buffer_rsrc((void*)gA, (short)0, 0x7fffffff, 0x00020000);
    const __amdgpu_buffer_rsrc_t srdB = __builtin_amdgcn_make_buffer_rsrc((void*)gB, (short)0, 0x7fffffff, 0x00020000);
    const unsigned kstep = (unsigned)(BK * 2);
    const unsigned hstepA = (unsigned)HALF * g.lda * 2u, hstepB = (unsigned)HALF * g.ldb * 2u;
    const unsigned tstepA = 2u * hstepA, tstepB = 2u * hstepB;
    const unsigned ldsw = (unsigned)wid * 1024u;
    const int aoff = lds_byte(wr * 64 + fr, fq * 8), boff = lds_byte(wc * 32 + fr, fq * 8);
#define PG8_SA(b, h) (((b) * 2 + (h)) * HTB)
#define PG8_SB(b, h) ((4 + (b) * 2 + (h)) * HTB)
#define PG8_STAGE(bufoff, srd, soff, voff) do { _Pragma("unroll") for (int _i = 0; _i < 2; ++_i) \
        __builtin_amdgcn_raw_ptr_buffer_load_lds(srd, (PG8_LAS unsigned*)(lds + (bufoff) + ldsw + _i * 8192), 16, (voff)[_i], (soff), 0, 0); } while (0)
#define PG8_LDA(dst, b, h) do { _Pragma("unroll") for (int m = 0; m < 4; ++m) _Pragma("unroll") for (int k = 0; k < 2; ++k) dst[m][k] = *(const PG8_LAS bf16x8*)(lds + PG8_SA(b, h) + aoff + m * 2048 + k * 1024); } while (0)
#define PG8_LDB(dst, b, h) do { _Pragma("unroll") for (int n = 0; n < 2; ++n) _Pragma("unroll") for (int k = 0; k < 2; ++k) dst[n][k] = *(const PG8_LAS bf16x8*)(lds + PG8_SB(b, h) + boff + n * 2048 + k * 1024); } while (0)
#define PG8_MMA(ai, bj, At, Bt) do { __builtin_amdgcn_s_setprio(1); _Pragma("unroll") for (int m = 0; m < 4; ++m) _Pragma("unroll") for (int n = 0; n < 2; ++n) _Pragma("unroll") for (int k = 0; k < 2; ++k) \
        acc[ai][bj][m][n] = __builtin_amdgcn_mfma_f32_16x16x32_bf16(Bt[n][k], At[m][k], acc[ai][bj][m][n], 0, 0, 0); __builtin_amdgcn_s_setprio(0); } while (0)
#define PG8_MMA0(ai, bj, At, Bt) do { __builtin_amdgcn_s_setprio(1); _Pragma("unroll") for (int m = 0; m < 4; ++m) _Pragma("unroll") for (int n = 0; n < 2; ++n) { \
        acc[ai][bj][m][n] = __builtin_amdgcn_mfma_f32_16x16x32_bf16(Bt[n][0], At[m][0], (f32x4){0.f, 0.f, 0.f, 0.f}, 0, 0, 0); \
        acc[ai][bj][m][n] = __builtin_amdgcn_mfma_f32_16x16x32_bf16(Bt[n][1], At[m][1], acc[ai][bj][m][n], 0, 0, 0); } __builtin_amdgcn_s_setprio(0); } while (0)
#define PG8_WAIT_V(n) asm volatile("s_waitcnt vmcnt(" #n ")" ::: "memory")
#define PG8_WAIT_L(n) asm volatile("s_waitcnt lgkmcnt(" #n ")" ::: "memory")
#define PG8_BAR __builtin_amdgcn_s_barrier()
#define PG8_SCHED __builtin_amdgcn_sched_barrier(0)
    Unit cur, nxt; int ui = 0;
    if (!S.next(0, cur)) return;
    f32x4 acc[2][2][4][2];
#pragma unroll
    for (int a = 0; a < 2; ++a)
#pragma unroll
        for (int b = 0; b < 2; ++b)
#pragma unroll
            for (int m = 0; m < 4; ++m)
#pragma unroll
                for (int n = 0; n < 2; ++n) acc[a][b][m][n] = (f32x4){0.f, 0.f, 0.f, 0.f};
    bf16x8 At[4][2], B0[2][2], B1[2][2];
    unsigned cA = (unsigned)cur.pm * tstepA + (unsigned)cur.pn * (unsigned)g.a_pn_off * 2u, cB = (unsigned)cur.pn * tstepB;
    PG8_STAGE(PG8_SB(0, 0), srdB, cB, voffB); PG8_STAGE(PG8_SB(0, 1), srdB, cB + hstepB, voffB); PG8_STAGE(PG8_SA(0, 0), srdA, cA, voffA); PG8_STAGE(PG8_SA(0, 1), srdA, cA + hstepA, voffA);
    if (wr == 1) PG8_BAR;
    PG8_WAIT_V(2); PG8_BAR;
    PG8_STAGE(PG8_SB(1, 0), srdB, cB + kstep, voffB); PG8_STAGE(PG8_SA(1, 0), srdA, cA + kstep, voffA); PG8_STAGE(PG8_SB(1, 1), srdB, cB + hstepB + kstep, voffB);
    PG8_WAIT_V(6); PG8_BAR;
    for (;;) {
        const bool has_next = S.next(ui + 1, nxt);
        const unsigned nA = has_next ? (unsigned)nxt.pm * tstepA + (unsigned)nxt.pn * (unsigned)g.a_pn_off * 2u : cA, nB = has_next ? (unsigned)nxt.pn * tstepB : cB;
        for (int t = 0; t < nt; t += 2) {
            const bool last = (t == nt - 2);
            const unsigned a1 = cA + (unsigned)(t + 1) * kstep;
            const unsigned a2 = last ? nA : cA + (unsigned)(t + 2) * kstep, b2 = last ? nB : cB + (unsigned)(t + 2) * kstep;
            const unsigned a3 = a2 + kstep, b3 = b2 + kstep;
            PG8_LDB(B0, 0, 0); PG8_LDB(B1, 0, 1); PG8_SCHED; PG8_LDA(At, 0, 0); PG8_STAGE(PG8_SA(1, 1), srdA, a1 + hstepA, voffA);
            PG8_WAIT_V(8); PG8_WAIT_L(0); PG8_BAR; if (t == 0) { PG8_MMA0(0, 0, At, B0); PG8_MMA0(0, 1, At, B1); } else { PG8_MMA(0, 0, At, B0); PG8_MMA(0, 1, At, B1); } PG8_BAR; PG8_SCHED;
            PG8_LDA(At, 0, 1); PG8_STAGE(PG8_SB(0, 0), srdB, b2, voffB); PG8_STAGE(PG8_SB(0, 1), srdB, b2 + hstepB, voffB); PG8_STAGE(PG8_SA(0, 0), srdA, a2, voffA);
            PG8_WAIT_V(8); PG8_WAIT_L(0); PG8_BAR; if (t == 0) { PG8_MMA0(1, 0, At, B0); PG8_MMA0(1, 1, At, B1); } else { PG8_MMA(1, 0, At, B0); PG8_MMA(1, 1, At, B1); } PG8_BAR; PG8_SCHED;
            PG8_LDB(B0, 1, 0); PG8_LDB(B1, 1, 1); PG8_SCHED; PG8_LDA(At, 1, 0); PG8_STAGE(PG8_SA(0, 1), srdA, a2 + hstepA, voffA);
            PG8_WAIT_V(8); PG8_WAIT_L(0); PG8_BAR; PG8_MMA(0, 0, At, B0); PG8_MMA(0, 1, At, B1); PG8_BAR; PG8_SCHED;
            PG8_LDA(At, 1, 1); PG8_STAGE(PG8_SB(1, 0), srdB, b3, voffB); PG8_STAGE(PG8_SB(1, 1), srdB, b3 + hstepB, voffB); PG8_STAGE(PG8_SA(1, 0), srdA, a3, voffA);
            PG8_WAIT_V(8); PG8_WAIT_L(0); PG8_BAR; PG8_MMA(1, 0, At, B0); PG8_MMA(1, 1, At, B1); PG8_BAR; PG8_SCHED;
        }
        if (wr == 0) PG8_BAR;
        E(acc, cur, wr, wc, fr, fq);
        if (!has_next) break;
        cur = nxt; cA = nA; cB = nB; ++ui;
        if (wr == 1) PG8_BAR;
    }
    PG8_WAIT_V(0);
    PG8_BAR;
#undef PG8_SA
#undef PG8_SB
#undef PG8_STAGE
#undef PG8_LDA
#undef PG8_LDB
#undef PG8_MMA
#undef PG8_MMA0
#undef PG8_WAIT_V
#undef PG8_WAIT_L
#undef PG8_BAR
#undef PG8_SCHED
}
}

namespace att {
constexpr int NW = 8, QBLK = 32, KVBLK = 64;
constexpr float SCALE = 0.07216878364870322f;
constexpr float THR = 8.f;
constexpr float QSCALE = SCALE * 1.4426950408889634f;
constexpr float THRL = THR * 1.4426950408889634f;
constexpr int LDQ = 1536, LDK = 2048, LDKR = 64, LDO = 1024;
constexpr int SHM_V = KVBLK * 128 * 2, SHM_K = KVBLK * 128 * 2, SHM_KR = KVBLK * 64 * 2;
constexpr int NBUF = 3;
constexpr int OFF_V = 0, OFF_K = NBUF * SHM_V, OFF_KR = OFF_K + NBUF * SHM_K, OFF_WS = OFF_KR + NBUF * SHM_KR, OFF_Q = OFF_WS + NW * 64 * 4, SHM_ATTN = OFF_Q + NW * 4 * 1024;
static_assert(SHM_ATTN <= LDS_MISC, "attention LDS fits below the barrier words");
#ifndef ATT_SDEPTH
#define ATT_SDEPTH 1
#endif
constexpr int SDEPTH = ATT_SDEPTH;
#define KSWZ(row, colB) ((row) * 256 + ((colB) ^ (((row) & 15) << 4)))
#define KRSWZ(row, colB) ((row) * 128 + ((colB) ^ ((((row) >> 1) & 7) << 4)))
#define SBAR() __builtin_amdgcn_sched_barrier(0)
__device__ __forceinline__ int crow(int r, int hi) { return (r & 3) + 8 * (r >> 2) + 4 * hi; }

template <bool FIRST> __device__ __forceinline__ void partialSM(f32x16& p0, f32x16& p1, f32x16& negm, float& alpha) {
    float pmax = p0[0];
#pragma unroll
    for (int r = 1; r < 16; ++r) pmax = fmaxf(pmax, p0[r]);
#pragma unroll
    for (int r = 0; r < 16; ++r) pmax = fmaxf(pmax, p1[r]);
    { auto rr = __builtin_amdgcn_permlane32_swap(__float_as_uint(pmax), __float_as_uint(pmax), false, false);
      pmax = fmaxf(__uint_as_float(rr[0]), __uint_as_float(rr[1])); }
    if (!FIRST && __builtin_expect(__all(pmax <= THRL), 1)) { alpha = 1.f; }
    else { const float d = FIRST ? pmax : fmaxf(pmax, 0.f); alpha = FIRST ? 1.f : __builtin_amdgcn_exp2f(-d);
#pragma unroll
        for (int r = 0; r < 16; ++r) { p0[r] -= d; p1[r] -= d; negm[r] -= d; } }
#pragma unroll
    for (int r = 0; r < 16; ++r) p0[r] = __builtin_amdgcn_exp2f(p0[r]);
}
__device__ __forceinline__ void finishSM(f32x16& p0, f32x16& p1, float alpha, float& l_reg, bf16x8& pa0, bf16x8& pa1, bf16x8& pa2, bf16x8& pa3) {
#pragma unroll
    for (int r = 0; r < 16; ++r) p1[r] = __builtin_amdgcn_exp2f(p1[r]);
    float ps = 0;
#pragma unroll
    for (int r = 0; r < 16; ++r) ps += p0[r];
#pragma unroll
    for (int r = 0; r < 16; ++r) ps += p1[r];
    { auto rr = __builtin_amdgcn_permlane32_swap(__float_as_uint(ps), __float_as_uint(ps), false, false);
      ps = __uint_as_float(rr[0]) + __uint_as_float(rr[1]); }
    l_reg = l_reg * alpha + ps;
#define PK4(P, BASE, OUT) do { unsigned a0 = cvtpk(P[BASE + 0], P[BASE + 1]), a1 = cvtpk(P[BASE + 2], P[BASE + 3]);   \
    unsigned b0 = cvtpk(P[BASE + 4], P[BASE + 5]), b1 = cvtpk(P[BASE + 6], P[BASE + 7]);                              \
    auto r0 = __builtin_amdgcn_permlane32_swap(a0, b0, false, false); auto r1 = __builtin_amdgcn_permlane32_swap(a1, b1, false, false); \
    u32x4 w = {r0[0], r1[0], r0[1], r1[1]}; OUT = __builtin_bit_cast(bf16x8, w); } while (0)
    PK4(p0, 0, pa0); PK4(p0, 8, pa1); PK4(p1, 0, pa2); PK4(p1, 8, pa3);
#undef PK4
}
#define LDSP(T, a) ((__attribute__((address_space(3))) T*)(uintptr_t)(a))
__device__ __forceinline__ void qkt(f32x16& p0, f32x16& p1, unsigned Ks, unsigned Krs, const bf16x8* qr, unsigned QL, const f32x16& negm, int r32, int hi) {
    p0 = negm; p1 = negm;
#pragma unroll
    for (int d0 = 0; d0 < 8; ++d0) { int cb = (d0 * 16 + hi * 8) * 2;
        bf16x8 b0 = *LDSP(const bf16x8, Ks + KSWZ(r32, cb));
        bf16x8 b1 = *LDSP(const bf16x8, Ks + KSWZ(32 + r32, cb));
        p0 = __builtin_amdgcn_mfma_f32_32x32x16_bf16(b0, qr[d0], p0, 0, 0, 0);
        p1 = __builtin_amdgcn_mfma_f32_32x32x16_bf16(b1, qr[d0], p1, 0, 0, 0); }
#pragma unroll
    for (int d0 = 0; d0 < 4; ++d0) { int cb = (d0 * 16 + hi * 8) * 2;
        bf16x8 b0 = *LDSP(const bf16x8, Krs + KRSWZ(r32, cb));
        bf16x8 b1 = *LDSP(const bf16x8, Krs + KRSWZ(32 + r32, cb));
        p0 = __builtin_amdgcn_mfma_f32_32x32x16_bf16(b0, qr[8 + d0], p0, 0, 0, 0);
        p1 = __builtin_amdgcn_mfma_f32_32x32x16_bf16(b1, qr[8 + d0], p1, 0, 0, 0); }
}
__device__ __forceinline__ int v_st(int k, int c) { const int kk = (k & ~0xC) | ((k & 4) << 1) | ((k & 8) >> 1); return ((kk >> 3) * 4 + (c >> 5)) * 512 + ((kk & 7) * 32 + (c & 31)) * 2; }
__device__ __forceinline__ int v_rd_base(int lane) { return ((lane & 3) << 3) | (((lane >> 2) & 3) << 6) | (((lane >> 4) & 1) << 5) | (((lane >> 5) & 1) << 8); }
constexpr int v_rd_off(int d0, int ks, int half) { return d0 * 512 + ks * 4096 + half * 2048; }
typedef short v4i16_t __attribute__((ext_vector_type(4)));
template <int OFF> __device__ __forceinline__ s16x4 tr_read(int vb) {
    return __builtin_bit_cast(s16x4, __builtin_amdgcn_ds_read_tr16_b64_v4i16((__attribute__((address_space(3))) v4i16_t*)(uintptr_t)(unsigned)(vb + OFF)));
}
template <int KS> __device__ __forceinline__ void pv_slice(f32x16* o, int vb, bf16x8 pa) {
    const s16x4 l0 = tr_read<v_rd_off(0, KS, 0)>(vb), h0 = tr_read<v_rd_off(0, KS, 1)>(vb), l1 = tr_read<v_rd_off(1, KS, 0)>(vb), h1 = tr_read<v_rd_off(1, KS, 1)>(vb);
    const s16x4 l2 = tr_read<v_rd_off(2, KS, 0)>(vb), h2 = tr_read<v_rd_off(2, KS, 1)>(vb), l3 = tr_read<v_rd_off(3, KS, 0)>(vb), h3 = tr_read<v_rd_off(3, KS, 1)>(vb);
#define PK(L, H) (bf16x8){L[0], L[1], L[2], L[3], H[0], H[1], H[2], H[3]}
    o[0] = __builtin_amdgcn_mfma_f32_32x32x16_bf16(pa, PK(l0, h0), o[0], 0, 0, 0);
    o[1] = __builtin_amdgcn_mfma_f32_32x32x16_bf16(pa, PK(l1, h1), o[1], 0, 0, 0);
    o[2] = __builtin_amdgcn_mfma_f32_32x32x16_bf16(pa, PK(l2, h2), o[2], 0, 0, 0);
    o[3] = __builtin_amdgcn_mfma_f32_32x32x16_bf16(pa, PK(l3, h3), o[3], 0, 0, 0);
#undef PK
}
__device__ __forceinline__ void pv_d0(f32x16* o, int vb, bf16x8 pa0, bf16x8 pa1, bf16x8 pa2, bf16x8 pa3) {
    pv_slice<0>(o, vb, pa0); pv_slice<1>(o, vb, pa1); pv_slice<2>(o, vb, pa2); pv_slice<3>(o, vb, pa3);
}
__device__ __forceinline__ void rope8(bf16x8 a, bf16x8 b, const float* cs, const float* sn, bf16x8& oa, bf16x8& ob) {
    const f32x4 c0 = *(const f32x4*)cs, c1 = *(const f32x4*)(cs + 4), s0 = *(const f32x4*)sn, s1 = *(const f32x4*)(sn + 4);
    float r1[8], r2[8];
#pragma unroll
    for (int e = 0; e < 8; ++e) { const float x1 = bf2f((unsigned short)a[e]), x2 = bf2f((unsigned short)b[e]); const float c = e < 4 ? c0[e & 3] : c1[e & 3], s = e < 4 ? s0[e & 3] : s1[e & 3];
        r1[e] = x1 * c - x2 * s; r2[e] = x2 * c + x1 * s; }
    u32x4 w1 = {cvtpk(r1[0], r1[1]), cvtpk(r1[2], r1[3]), cvtpk(r1[4], r1[5]), cvtpk(r1[6], r1[7])};
    u32x4 w2 = {cvtpk(r2[0], r2[1]), cvtpk(r2[2], r2[3]), cvtpk(r2[4], r2[5]), cvtpk(r2[6], r2[7])};
    oa = __builtin_bit_cast(bf16x8, w1); ob = __builtin_bit_cast(bf16x8, w2);
}

__device__ __forceinline__ void attn_unit(const bf16_t* __restrict__ Qb, const bf16_t* __restrict__ Kh, const bf16_t* __restrict__ Vh, const bf16_t* __restrict__ Kr,
                                          bf16_t* __restrict__ Ob, const float* __restrict__ cosT, const float* __restrict__ sinT, int pos0, int seq, char* lds) {
    const int tid = tid_opaque(), wid = tid >> 6, lane = tid & 63, r32 = lane & 31, hi = lane >> 5;
    unsigned lbase = (unsigned)(uintptr_t)(__attribute__((address_space(3))) char*)lds;
    unsigned V_lds = lbase + OFF_V, K_lds = lbase + OFF_K, KR_lds = lbase + OFF_KR;
    asm volatile("" : "+s"(V_lds), "+s"(K_lds), "+s"(KR_lds));
    const unsigned QL = lbase + OFF_Q + wid * 4096 + lane * 16;
    float* ws = (float*)(lds + OFF_WS) + wid * 64; float* li_l = ws; float* al_l = ws + 32;
    float l_reg = 0; f32x16 o[4] = {}; f32x16 negm = {}; bf16x8 qr[12];
    const bf16_t* Qw = Qb + (size_t)(wid * QBLK + r32) * LDQ + hi * 8;
#pragma unroll
    for (int d0 = 0; d0 < 8; ++d0) qr[d0] = *reinterpret_cast<const bf16x8*>(Qw + d0 * 16);
    { const bf16x8 a0 = *reinterpret_cast<const bf16x8*>(Qw + 128), a1 = *reinterpret_cast<const bf16x8*>(Qw + 144),
                   b0 = *reinterpret_cast<const bf16x8*>(Qw + 160), b1 = *reinterpret_cast<const bf16x8*>(Qw + 176);
      const int pos = pos0 + wid * QBLK + r32; const float* cs = cosT + pos * 32 + hi * 8; const float* sn = sinT + pos * 32 + hi * 8;
      rope8(a0, b0, cs, sn, qr[8], qr[10]); rope8(a1, b1, cs + 16, sn + 16, qr[9], qr[11]); }
    const int wu = __builtin_amdgcn_readfirstlane(wid);
    unsigned koff[2], vofs[2], roff;
#pragma unroll
    for (int i = 0; i < 2; ++i) { const int ch = (2 * wid + i) * 64 + lane;
        { const int row = ch >> 4, c = (ch & 15) ^ (row & 15); koff[i] = (unsigned)(row * LDK * 2 + c * 16); }
        { const int sub = ch >> 5, kk = ((sub >> 2) << 3) + ((ch & 31) >> 2), c = ((sub & 3) << 5) + ((ch & 3) << 3), k = (kk & ~0xC) | ((kk & 4) << 1) | ((kk & 8) >> 1);
          vofs[i] = (unsigned)(k * LDK * 2 + c * 2); } }
    { const int ch = wid * 64 + lane, row = ch >> 3, c = (ch & 7) ^ ((row >> 1) & 7); roff = (unsigned)(row * LDKR * 2 + c * 16); }
    const int vb0 = (int)V_lds + v_rd_base(lane);
    const __amdgpu_buffer_rsrc_t srdK = __builtin_amdgcn_make_buffer_rsrc((void*)Kh, (short)0, (int)(SEQ * LDK * 2 - 256), 0x00020000);
    const __amdgpu_buffer_rsrc_t srdV = __builtin_amdgcn_make_buffer_rsrc((void*)Vh, (short)0, (int)(SEQ * LDK * 2 - 256), 0x00020000);
    const __amdgpu_buffer_rsrc_t srdR = __builtin_amdgcn_make_buffer_rsrc((void*)Kr, (short)0, (int)(SEQ * LDKR * 2), 0x00020000);
#define DMA(b, k0) do { const unsigned so_ = (unsigned)(k0) * (LDK * 2), sr_ = (unsigned)(k0) * (LDKR * 2); \
    _Pragma("unroll") for (int _i = 0; _i < 2; ++_i) { \
        __builtin_amdgcn_raw_ptr_buffer_load_lds(srdK, LDSP(unsigned, K_lds + (b) * SHM_K + (2 * wu + _i) * 1024), 16, koff[_i], so_, 0, 0); \
        __builtin_amdgcn_raw_ptr_buffer_load_lds(srdV, LDSP(unsigned, V_lds + (b) * SHM_V + (2 * wu + _i) * 1024), 16, vofs[_i], so_, 0, 0); } \
    __builtin_amdgcn_raw_ptr_buffer_load_lds(srdR, LDSP(unsigned, KR_lds + (b) * SHM_KR + wu * 1024), 16, roff, sr_, 0, 0); } while (0)
#define DMAWAIT() asm volatile("s_waitcnt vmcnt(0)" ::: "memory")
#define RESC(a) do { if (__any((a) < 1.f)) { if (hi == 0) al_l[r32] = (a); asm volatile("s_waitcnt lgkmcnt(0)" ::: "memory"); \
    _Pragma("unroll") for (int d = 0; d < 4; ++d) _Pragma("unroll") for (int r = 0; r < 16; ++r) o[d][r] *= al_l[crow(r, hi)]; } } while (0)
    f32x16 pA0, pA1, pB0, pB1; float alA, alB; bf16x8 pa0, pa1, pa2, pa3; const int NT = seq / KVBLK;
    static_assert(SDEPTH == 1, "ring form stages one tile ahead");
#define STEP(PX0, PX1, alX, PY0, PY1, alY, KB, VB, WB, K0NEXT, HASNEXT) do { \
        SBAR(); if (HASNEXT) DMA(WB, K0NEXT); SBAR(); \
        qkt(PX0, PX1, K_lds + (KB) * SHM_K, KR_lds + (KB) * SHM_KR, qr, QL, negm, r32, hi); \
        finishSM(PY0, PY1, alY, l_reg, pa0, pa1, pa2, pa3); SBAR(); \
        pv_d0(o, vb0 + (VB) * SHM_V, pa0, pa1, pa2, pa3); partialSM<false>(PX0, PX1, negm, alX); SBAR(); \
        RESC(alX); SBAR(); \
        DMAWAIT(); __syncthreads(); SBAR(); } while (0)
    __syncthreads();
    DMA(0, 0); DMAWAIT(); __syncthreads();
    qkt(pA0, pA1, K_lds, KR_lds, qr, QL, negm, r32, hi); partialSM<true>(pA0, pA1, negm, alA);
    DMA(1, KVBLK); DMAWAIT(); __syncthreads();
    for (int j = 1; j + 6 <= NT - 1; j += 6) {
        STEP(pB0, pB1, alB, pA0, pA1, alA, 1, 0, 2, (j + 1) * KVBLK, true);
        STEP(pA0, pA1, alA, pB0, pB1, alB, 2, 1, 0, (j + 2) * KVBLK, true);
        STEP(pB0, pB1, alB, pA0, pA1, alA, 0, 2, 1, (j + 3) * KVBLK, true);
        STEP(pA0, pA1, alA, pB0, pB1, alB, 1, 0, 2, (j + 4) * KVBLK, true);
        STEP(pB0, pB1, alB, pA0, pA1, alA, 2, 1, 0, (j + 5) * KVBLK, true);
        STEP(pA0, pA1, alA, pB0, pB1, alB, 0, 2, 1, (j + 6) * KVBLK, true);
    }
    STEP(pB0, pB1, alB, pA0, pA1, alA, 1, 0, 0, 0, false);
    finishSM(pB0, pB1, alB, l_reg, pa0, pa1, pa2, pa3); SBAR();
    pv_d0(o, vb0 + 1 * SHM_V, pa0, pa1, pa2, pa3);
#undef STEP
    {
      const int tid2 = tid_opaque(), wid2 = tid2 >> 6, r32e = tid2 & 31, hie = (tid2 >> 5) & 1;
      float* li2 = (float*)(lds + OFF_WS) + wid2 * 64;
      if (hie == 0) li2[r32e] = l_reg; asm volatile("s_waitcnt lgkmcnt(0)" ::: "memory");
      float rli[16];
#pragma unroll
      for (int r = 0; r < 16; ++r) rli[r] = __builtin_amdgcn_rcpf(li2[crow(r, hie)]);
      bf16_t* Ow = Ob + (size_t)(wid2 * QBLK) * LDO;
#pragma unroll
      for (int r = 0; r < 16; ++r) { int orow = crow(r, hie);
#pragma unroll
          for (int d0 = 0; d0 < 4; ++d0) Ow[(size_t)orow * LDO + d0 * 32 + r32e] = (bf16_t)f2bf(o[d0][r] * rli[r]); } }
#undef DMA
#undef DMAWAIT
#undef RESC
}
}

__device__ const double INVF[32] = {
    1.0, 0.7498942093324559, 0.5623413251903491, 0.4216965034285822, 0.31622776601683794, 0.23713737056616552, 0.1778279410038923, 0.1333521432163324,
    0.1, 0.07498942093324558, 0.05623413251903491, 0.042169650342858224, 0.03162277660168379, 0.023713737056616554, 0.01778279410038923, 0.01333521432163324,
    0.01, 0.007498942093324558, 0.005623413251903491, 0.004216965034285823, 0.0031622776601683794, 0.0023713737056616554, 0.0017782794100389228, 0.001333521432163324,
    0.001, 0.0007498942093324559, 0.0005623413251903491, 0.00042169650342858224, 0.00031622776601683794, 0.00023713737056616554, 0.00017782794100389227, 0.0001333521432163324};

struct Params { const float* in[24]; float* out; unsigned char* ws; };

__device__ __forceinline__ void tables_phase(float* cosT, float* sinT) {
    for (int i = blockIdx.x * NTHREADS + tid_opaque(); i < SEQ * 32; i += gridDim.x * NTHREADS) {
        const int pos = i >> 5, j = i & 31;
        const double rev = (double)pos * INVF[j] * 0.15915494309189535;
        const float fr = (float)(rev - __builtin_rint(rev));
        cosT[i] = __builtin_amdgcn_cosf(fr); sinT[i] = __builtin_amdgcn_sinf(fr);
    }
}
__device__ __forceinline__ void mod_phase(const Params& p, float* mod, float* lds) {
    const int tid = tid_opaque(), kg = tid >> 7, col = tid & 127;
    float* sc = lds;
    float* red = lds + 6 * 1024;
    const float* cp = p.in[2]; const float* csmp = p.in[3];
    for (int i = tid; i < 6 * 1024; i += NTHREADS) { const int b = i >> 10, k = i & 1023; const float c = b < 4 ? cp[b * 1024 + k] : csmp[(b - 4) * 1024 + k]; sc[i] = c * sigmoidf_(c); }
    __syncthreads();
    const int nitem = DEPTH * (NMOD * DM / 128);
    for (int it = blockIdx.x; it < nitem; it += gridDim.x) {
        const int l = it / 72, n0 = (it % 72) * 128;
        const float* w = p.in[4] + (size_t)l * DM * (NMOD * DM) + n0 + col;
        float a0 = 0, a1 = 0, a2 = 0, a3 = 0, a4 = 0, a5 = 0;
#pragma unroll 16
        for (int k = kg * 256; k < kg * 256 + 256; ++k) { const float wv = __builtin_nontemporal_load(w + (size_t)k * (NMOD * DM));
            a0 += sc[k] * wv; a1 += sc[1024 + k] * wv; a2 += sc[2048 + k] * wv; a3 += sc[3072 + k] * wv; a4 += sc[4096 + k] * wv; a5 += sc[5120 + k] * wv; }
        float* rr = red + (kg * 6) * 128 + col;
        rr[0] = a0; rr[128] = a1; rr[256] = a2; rr[384] = a3; rr[512] = a4; rr[640] = a5;
        __syncthreads();
        for (int i = tid; i < 6 * 128; i += NTHREADS) { const int b = i >> 7, c = i & 127;
            const float s = red[(0 * 6 + b) * 128 + c] + red[(1 * 6 + b) * 128 + c] + red[(2 * 6 + b) * 128 + c] + red[(3 * 6 + b) * 128 + c];
            mod[((size_t)(l * NSEQ + b)) * (NMOD * DM) + n0 + c] = s + p.in[5][(size_t)l * (NMOD * DM) + n0 + c]; }
        __syncthreads();
    }
}

struct WDesc { const float* src; bf16_t* dst; int ldsrc, kvalid, kdst, ndst, mode, base0, base1, nvalid; };
__device__ __forceinline__ void cvt_one(const WDesc d, float* tile) {
    const int tid = tid_opaque();
    const int ntk = d.kdst >> 6, ntn = d.ndst >> 6, nt = ntk * ntn;
    for (int t = blockIdx.x; t < nt; t += gridDim.x) {
        const int n0 = (t / ntk) * 64, k0 = (t % ntk) * 64;
        int sc;
        if (d.mode == 0) sc = n0 < d.nvalid ? d.base0 + n0 : -1;
        else { const int pn = n0 >> 8, i = n0 & 255; sc = (i < 128 ? d.base0 : d.base1) + 128 * pn + (i & 127); }
        const bool valid = sc >= 0 && k0 < d.kvalid;
        __syncthreads();
        if (valid) {
#pragma unroll
            for (int i = 0; i < 2; ++i) { const int e = tid + i * 512, kk = e >> 4, j4 = (e & 15) * 4;
                const f32x4 v = __builtin_nontemporal_load((const f32x4*)(d.src + (size_t)(k0 + kk) * d.ldsrc + sc + j4));
                float* tp = tile + kk * 65 + j4; tp[0] = v[0]; tp[1] = v[1]; tp[2] = v[2]; tp[3] = v[3]; }
        }
        __syncthreads();
        const int j = tid >> 3, kc = (tid & 7) * 8;
        u32x4 w = {0u, 0u, 0u, 0u};
        if (valid) { const float* tp = tile + kc * 65 + j;
            w.x = pk2(tp[0], tp[65]); w.y = pk2(tp[130], tp[195]); w.z = pk2(tp[260], tp[325]); w.w = pk2(tp[390], tp[455]); }
        *(u32x4*)(d.dst + (size_t)(n0 + j) * d.kdst + k0 + kc) = w;
    }
}
__device__ __forceinline__ void cvt_phase(const Params& p, int l, bf16_t* W, float* tile) {
#pragma nounroll
    for (int wi = 0; wi < 13; ++wi) {
        WDesc d;
        switch (wi) {
        case 0: d = WDesc{p.in[7] + (size_t)l * DM * 2 * DFF, W + WO_1GU, 2 * DFF, DM, DM, 2 * DFF, 1, 0, DFF, 0}; break;
        case 1: d = WDesc{p.in[8] + (size_t)l * DFF * DM, W + WO_1DN, DM, DFF, DFF, DM, 0, 0, 0, DM}; break;
        case 2: d = WDesc{p.in[11] + (size_t)l * DM * INW, W + WO_INA, INW, DM, DM, ZSW, 0, 0, 0, O4}; break;
        case 3: d = WDesc{p.in[11] + (size_t)l * DM * INW, W + WO_ING, INW, DM, DM, 2048, 1, O4, O4 + 1024, 0}; break;
        case 4: d = WDesc{p.in[13] + (size_t)l * QLR * 1536, W + WO_QB, 1536, QLR, 256, 1536, 0, 0, 0, 1536}; break;
        case 5: d = WDesc{p.in[15] + (size_t)l * KVLR * 2048, W + WO_KVB, 2048, KVLR, 256, 2048, 0, 0, 0, 2048}; break;
        case 6: case 7: case 8: case 9: { const int g = wi - 6;
            d = WDesc{p.in[16] + ((size_t)l * 4 + g) * 256 * 256, W + WO_POOL + (size_t)g * 256 * 256, 256, 256, 256, 256, 0, 0, 0, 256}; break; }
        case 10: d = WDesc{p.in[18] + (size_t)l * DM * DM, W + WO_OUT, DM, DM, DM, DM, 0, 0, 0, DM}; break;
        case 11: d = WDesc{p.in[21] + (size_t)l * DM * 2 * DFF, W + WO_2GU, 2 * DFF, DM, DM, 2 * DFF, 1, 0, DFF, 0}; break;
        default: d = WDesc{p.in[22] + (size_t)l * DFF * DM, W + WO_2DN, DM, DFF, DFF, DM, 0, 0, 0, DM}; break;
        }
        cvt_one(d, tile);
    }
}

struct RowArgs { const float* xp; const float* xs; float* xout; const bf16_t* y; const float* post; const float* gate; float gfac; const float* pre; const float* shift; const float* scale; bf16_t* h; };
__device__ __forceinline__ void row_phase(const float* a_xp, const float* a_xs, float* a_xout, const bf16_t* a_y, const float* a_post, const float* a_gate, const float a_gfac, const float* a_pre, const float* a_shift, const float* a_scale, bf16_t* a_h, const bool a_wx) {
    constexpr int RG = 4;
    const int tid = tid_opaque(), wid = tid >> 6, lane = tid & 63;
    for (int g = blockIdx.x * 8 + wid; g < NTOK / RG; g += gridDim.x * 8) {
        const int r0 = g * RG, b = r0 >> 13;
        f32x4 x[RG][4]; u32x2 yw[RG][4];
#pragma unroll
        for (int q = 0; q < RG; ++q) { const int r = r0 + q;
            const float* xin = a_xp ? (r < NPROMPT_TOK ? a_xp + (size_t)r * DM : a_xs + (size_t)(r - NPROMPT_TOK) * DM) : a_xout + (size_t)r * DM;
#pragma unroll
            for (int i = 0; i < 4; ++i) x[q][i] = __builtin_nontemporal_load((const f32x4*)(xin + i * 256 + lane * 4));
            if (a_y) {
#pragma unroll
                for (int i = 0; i < 4; ++i) yw[q][i] = __builtin_nontemporal_load((const u32x2*)(a_y + (size_t)r * DM + i * 256 + lane * 4)); } }
        if (a_y) {
            f32x4 pg[4], gv[4];
            const float* gt = a_gate + (size_t)b * (NMOD * DM);
#pragma unroll
            for (int i = 0; i < 4; ++i) { pg[i] = *(const f32x4*)(a_post + i * 256 + lane * 4); gv[i] = *(const f32x4*)(gt + i * 256 + lane * 4); pg[i] = pg[i] * gv[i] * a_gfac; }
#pragma unroll
            for (int q = 0; q < RG; ++q) {
                f32x4 yv[4]; float ss = 0;
#pragma unroll
                for (int i = 0; i < 4; ++i) { const u32x2 w = yw[q][i];
                    yv[i] = (f32x4){__builtin_bit_cast(float, w.x << 16), __builtin_bit_cast(float, w.x & 0xffff0000u), __builtin_bit_cast(float, w.y << 16), __builtin_bit_cast(float, w.y & 0xffff0000u)};
                    ss += yv[i][0] * yv[i][0] + yv[i][1] * yv[i][1] + yv[i][2] * yv[i][2] + yv[i][3] * yv[i][3]; }
                ss = wave_sum(ss, lane);
                const float rs = __builtin_amdgcn_rsqf(ss * (1.f / DM) + EPS);
#pragma unroll
                for (int i = 0; i < 4; ++i) x[q][i] += pg[i] * (yv[i] * rs);
            }
        }
        if (a_wx) {
#pragma unroll
            for (int q = 0; q < RG; ++q)
#pragma unroll
                for (int i = 0; i < 4; ++i) __builtin_nontemporal_store(x[q][i], (f32x4*)(a_xout + (size_t)(r0 + q) * DM + i * 256 + lane * 4));
        }
        if (a_h) {
            const float* sh = a_shift + (size_t)b * (NMOD * DM); const float* scl = a_scale + (size_t)b * (NMOD * DM);
            f32x4 pg[4], sv[4];
#pragma unroll
            for (int i = 0; i < 4; ++i) { pg[i] = *(const f32x4*)(a_pre + i * 256 + lane * 4); sv[i] = *(const f32x4*)(sh + i * 256 + lane * 4); const f32x4 cv = *(const f32x4*)(scl + i * 256 + lane * 4); pg[i] = pg[i] * (cv + 1.f); }
#pragma unroll
            for (int q = 0; q < RG; ++q) {
                float ss = 0;
#pragma unroll
                for (int i = 0; i < 4; ++i) ss += x[q][i][0] * x[q][i][0] + x[q][i][1] * x[q][i][1] + x[q][i][2] * x[q][i][2] + x[q][i][3] * x[q][i][3];
                ss = wave_sum(ss, lane);
                const float rs = __builtin_amdgcn_rsqf(ss * (1.f / DM) + EPS);
#pragma unroll
                for (int i = 0; i < 4; ++i) { const f32x4 hv = (x[q][i] * rs) * pg[i] + sv[i];
                    u32x2 w; w.x = cvtpk(hv[0], hv[1]); w.y = cvtpk(hv[2], hv[3]);
                    *(u32x2*)(a_h + (size_t)(r0 + q) * DM + i * 256 + lane * 4) = w; }
            }
        }
    }
}

template <int GP> __device__ __forceinline__ void pool_group(const bf16_t* zs, bf16_t* pooled, int r, int t, int lane) {
    constexpr int half = 1 << GP, NW2 = 2 * half;
    const int lo = t - half < 0 ? 0 : t - half, hi = t + half > SEQ ? SEQ : t + half;
    const bf16_t* ub = zs + (size_t)(r - t) * ZSW + 448 + GP * 256 + lane * 4;
    u32x2 wv[NW2];
#pragma unroll
    for (int j = 0; j < NW2; ++j) { int tt = t - half + j; tt = tt < 0 ? 0 : (tt > SEQ - 1 ? SEQ - 1 : tt); wv[j] = *(const u32x2*)(ub + (size_t)tt * ZSW); }
    float s0 = 0, s1 = 0, s2 = 0, s3 = 0;
#pragma unroll
    for (int j = 0; j < NW2; ++j) { const int tt = t - half + j; const bool ok = tt >= 0 && tt < SEQ; const u32x2 w = wv[j];
        s0 += ok ? __builtin_bit_cast(float, w.x << 16) : 0.f; s1 += ok ? __builtin_bit_cast(float, w.x & 0xffff0000u) : 0.f;
        s2 += ok ? __builtin_bit_cast(float, w.y << 16) : 0.f; s3 += ok ? __builtin_bit_cast(float, w.y & 0xffff0000u) : 0.f; }
    const float inv = 1.f / (float)(hi - lo);
    const u32x2 w = wv[half];
    const float u0 = __builtin_bit_cast(float, w.x << 16), u1 = __builtin_bit_cast(float, w.x & 0xffff0000u), u2 = __builtin_bit_cast(float, w.y << 16), u3 = __builtin_bit_cast(float, w.y & 0xffff0000u);
    u32x2 o; o.x = cvtpk(s0 * inv - u0, s1 * inv - u1); o.y = cvtpk(s2 * inv - u2, s3 * inv - u3);
    *(u32x2*)(pooled + (size_t)r * DM + GP * 256 + lane * 4) = o;
}
__device__ __forceinline__ void prep_phase(const bf16_t* zs, bf16_t* qn, bf16_t* kvn, bf16_t* krope, bf16_t* pooled, const float* qg, const float* kvg, const float* cosT, const float* sinT) {
    const int tid = tid_opaque(), wid = tid >> 6, lane = tid & 63;
#pragma unroll 2
    for (int r = blockIdx.x * 8 + wid; r < CTOK; r += gridDim.x * 8) {
        const int t = r & (SEQ - 1);
        const bf16_t* z = zs + (size_t)r * ZSW;
        { const u32x2 w = *(const u32x2*)(z + lane * 4);
          const float v0 = __builtin_bit_cast(float, w.x << 16), v1 = __builtin_bit_cast(float, w.x & 0xffff0000u), v2 = __builtin_bit_cast(float, w.y << 16), v3 = __builtin_bit_cast(float, w.y & 0xffff0000u);
          const float ss = wave_sum(v0 * v0 + v1 * v1 + v2 * v2 + v3 * v3, lane);
          const float rs = __builtin_amdgcn_rsqf(ss * (1.f / QLR) + EPS);
          const f32x4 g = *(const f32x4*)(qg + lane * 4);
          u32x2 o; o.x = cvtpk(v0 * rs * g[0], v1 * rs * g[1]); o.y = cvtpk(v2 * rs * g[2], v3 * rs * g[3]);
          *(u32x2*)(qn + (size_t)r * 256 + lane * 4) = o; }
        { const unsigned w = *(const unsigned*)(z + QLR + lane * 2);
          const float v0 = __builtin_bit_cast(float, w << 16), v1 = __builtin_bit_cast(float, w & 0xffff0000u);
          const float ss = wave_sum(v0 * v0 + v1 * v1, lane);
          const float rs = __builtin_amdgcn_rsqf(ss * (1.f / KVLR) + EPS);
          *(unsigned*)(kvn + (size_t)r * 256 + lane * 2) = cvtpk(v0 * rs * kvg[lane * 2], v1 * rs * kvg[lane * 2 + 1]);
          *(unsigned*)(kvn + (size_t)r * 256 + 128 + lane * 2) = 0u; }
        { const float kr = bf2f(z[QLR + KVLR + lane]); const float pr = shfl_xor_l(kr, 32, lane);
          const int j = lane & 31; const float c = cosT[t * 32 + j], s = sinT[t * 32 + j];
          const float o = lane < 32 ? kr * c - pr * s : kr * c + pr * s;
          krope[(size_t)r * 64 + lane] = (bf16_t)f2bf(o); }
        pool_group<0>(zs, pooled, r, t, lane); pool_group<1>(zs, pooled, r, t, lane); pool_group<2>(zs, pooled, r, t, lane); pool_group<3>(zs, pooled, r, t, lane);
    }
}

__device__ __forceinline__ void attn_phase(const bf16_t* q, const bf16_t* kv, const bf16_t* krope, bf16_t* oa, const float* cosT, const float* sinT, char* lds) {
    const int G = gridDim.x, bid = blockIdx.x;
    constexpr int NPAIR = CSEQ * NHEAD, NQB = SEQ / 256, NUNIT = NPAIR * NQB;
    for (int i = 0;; ++i) {
        int pair, qb;
        if ((G & 7) == 0) { const int xcd = bid & 7, slot = bid >> 3, j = i * (G >> 3) + slot; pair = (j / NQB) * 8 + xcd; qb = j % NQB; if (pair >= NPAIR) break; }
        else { const int u = i * G + bid; if (u >= NUNIT) break; pair = u / NQB; qb = u % NQB; }
        const int s = pair / NHEAD, h = pair % NHEAD;
        const size_t row0 = (size_t)s * SEQ + (size_t)qb * 256, key0 = (size_t)s * SEQ;
        att::attn_unit(q + row0 * 1536 + h * 192, kv + key0 * 2048 + h * 256, kv + key0 * 2048 + h * 256 + 128, krope + key0 * 64,
                       oa + row0 * 1024 + h * 128, cosT, sinT, qb * 256, SEQ, lds);
    }
}

constexpr int STEPS = 4 + 5 * NCHUNK + 4;

__global__ void __launch_bounds__(NTHREADS, 2) fwd_megakernel(Params p) {
    extern __shared__ __attribute__((aligned(16))) unsigned char lds[];
    cg::grid_group grid = cg::this_grid();
    unsigned char* ws = p.ws;
    float* mod = (float*)(ws + WS_MOD); float* cosT = (float*)(ws + WS_COS); float* sinT = (float*)(ws + WS_SIN);
    bf16_t* W = (bf16_t*)(ws + WS_W); bf16_t* H = (bf16_t*)(ws + WS_H); bf16_t* Y = (bf16_t*)(ws + WS_Y);
    unsigned char* big = ws + WS_BIG; bf16_t* ACT = (bf16_t*)big;
    bf16_t* ZS = (bf16_t*)(ws + WS_ZS); bf16_t* MG = (bf16_t*)(big + MX_ZS); bf16_t* QN = (bf16_t*)(big + MX_QN); bf16_t* KVN = (bf16_t*)(big + MX_KVN); bf16_t* KR = (bf16_t*)(big + MX_KR);
    bf16_t* PL = (bf16_t*)(big + MX_PL); bf16_t* Q = (bf16_t*)(big + MX_Q); bf16_t* KV = (bf16_t*)(big + MX_KV); bf16_t* OA = (bf16_t*)(big + MX_OA); bf16_t* OP = (bf16_t*)(big + MX_OP);
    PG8_LAS unsigned char* ldsl = (PG8_LAS unsigned char*)lds;
    const int G = gridDim.x, bid = blockIdx.x;

    volatile LAS unsigned* misc = (volatile LAS unsigned*)((LAS unsigned char*)lds + LDS_MISC);
    if (threadIdx.x < 4) misc[threadIdx.x] = 0u;
    __syncthreads();
    const XcdBarrier bar = xcd_barrier_post((unsigned*)(ws + WS_BAR), misc);
    tables_phase(cosT, sinT);
    mod_phase(p, mod, (float*)lds);
    cvt_phase(p, 0, W, (float*)lds);
    grid.sync();

#pragma nounroll
    for (int ph = -1; ph < DEPTH * STEPS; ++ph) {
        const int l = ph < 0 ? 0 : ph / STEPS, s = ph < 0 ? -1 : ph % STEPS;
        const float* modl = mod + (size_t)l * NSEQ * NMOD * DM;
        int kind;
        int c = 0, k = 0;
        if (s < 0 || s == 2 || s == STEPS - 4 || s == STEPS - 1) kind = 0;
        else if (s == 0 || s == STEPS - 3) kind = 1;
        else if (s == 1 || s == STEPS - 2) kind = 2;
        else if (s == 3) { k = 0; kind = 2; }
        else { c = (s - 4) / 5; k = (s - 4) % 5 + 1; kind = k == 1 ? 3 : k == 2 ? 2 : k == 3 ? 4 : k == 4 ? 5 : 2; }
        const size_t crow0 = (size_t)c * CTOK;

        if (kind == 0) {
            const float* r_xp = nullptr; const float* r_xs = nullptr; const bf16_t* r_y = Y; const float* r_post; const float* r_gate; float r_gfac = 0.5f; const float* r_pre; const float* r_shift; const float* r_scale; bf16_t* r_h = H;
            if (s < 0) { r_xp = p.in[0]; r_xs = p.in[1]; r_y = nullptr; r_post = nullptr; r_gate = nullptr; r_pre = p.in[6]; r_shift = modl + 0 * DM; r_scale = modl + 1 * DM; }
            else if (s == 2) { if (l == 0) { r_xp = p.in[0]; r_xs = p.in[1]; } r_post = p.in[9] + l * DM; r_gate = modl + 2 * DM; r_pre = p.in[10] + l * DM; r_shift = modl + 3 * DM; r_scale = modl + 4 * DM; }
            else if (s == STEPS - 4) { r_post = p.in[19] + l * DM; r_gate = modl + 5 * DM; r_gfac = 1.f; r_pre = p.in[20] + l * DM; r_shift = modl + 6 * DM; r_scale = modl + 7 * DM; }
            else { const bool more = l + 1 < DEPTH; const float* modn = modl + (size_t)NSEQ * NMOD * DM;
                r_post = p.in[23] + l * DM; r_gate = modl + 8 * DM; r_pre = more ? p.in[6] + (l + 1) * DM : nullptr; r_shift = modn + 0 * DM; r_scale = modn + 1 * DM; r_h = more ? H : nullptr; }
            row_phase(r_xp, r_xs, p.out, r_y, r_post, r_gate, r_gfac, r_pre, r_shift, r_scale, r_h, s >= 0);
            if (s == STEPS - 1 && l + 1 < DEPTH) cvt_phase(p, l + 1, W, (float*)lds);
        } else if (kind == 1) {
            const bool second = s != 0;
            pg8::Gemm g{H, W + (second ? WO_2GU : WO_1GU), NTOK, 2 * DFF, DM, DM, DM, 0};
            pg8::StaticOrder S; S.init(NTOK, 2 * DFF, G, bid);
            pg8::Epi<1> E{ACT, DFF, nullptr, nullptr, nullptr, 1.f};
            pg8::gemm_phase(ldsl, g, S, E);
        } else if (kind == 2) {
            const int ng = (s >= 4 && s < STEPS - 4 && k == 2) ? 3 : 1;
#pragma nounroll
            for (int gi = 0; gi < ng; ++gi) {
                pg8::Gemm g; pg8::Epi<0> E;
                if (s == 1 || s == STEPS - 2) { g = pg8::Gemm{ACT, W + (s == 1 ? WO_1DN : WO_2DN), NTOK, DM, DFF, DFF, DFF, 0}; E = pg8::Epi<0>{Y, DM, nullptr, nullptr, nullptr, 1.f}; }
                else if (k == 0) { g = pg8::Gemm{H, W + WO_INA, NTOK, ZSW, DM, DM, DM, 0}; E = pg8::Epi<0>{ZS, ZSW, nullptr, nullptr, nullptr, 1.f}; }
                else if (k == 5) { g = pg8::Gemm{MG, W + WO_OUT, CTOK, DM, DM, DM, DM, 0}; E = pg8::Epi<0>{Y + crow0 * DM, DM, nullptr, nullptr, nullptr, 1.f}; }
                else if (gi == 0) { g = pg8::Gemm{KVN, W + WO_KVB, CTOK, 2048, 128, 256, 256, 0};     E = pg8::Epi<0>{KV, 2048, nullptr, nullptr, nullptr, 1.f}; }
                else if (gi == 1) { g = pg8::Gemm{QN, W + WO_QB, CTOK, 1536, 256, 256, 256, 0}; E = pg8::Epi<0>{Q, 1536, nullptr, nullptr, nullptr, att::QSCALE}; }
                else { g = pg8::Gemm{PL, W + WO_POOL, CTOK, DM, 256, DM, 256, 256}; E = pg8::Epi<0>{OP, DM, p.in[17] + l * DM, nullptr, nullptr, 1.f}; }
                pg8::StaticOrder S; S.init(g.M, g.N, G, bid);
                pg8::gemm_phase(ldsl, g, S, E);
            }
        } else if (kind == 3) {
            prep_phase(ZS + crow0 * ZSW, QN, KVN, KR, PL, p.in[12] + l * QLR, p.in[14] + l * KVLR, cosT, sinT);
        } else if (kind == 4) {
            attn_phase(Q, KV, KR, OA, cosT, sinT, (char*)lds);
        } else {
            pg8::Gemm g{H + crow0 * DM, W + WO_ING, CTOK, 2048, DM, DM, DM, 0};
            pg8::StaticOrder S; S.init(CTOK, 2048, G, bid);
            pg8::Epi<2> E{MG, DM, nullptr, OA, OP, 1.f};
            pg8::gemm_phase(ldsl, g, S, E);
        }
        if (ph + 1 < DEPTH * STEPS) xcd_barrier(bar);
    }
}

extern "C" void kernel_launch(void* const* d_in, const int* in_sizes, int n_in, void* d_out, int out_size, void* d_ws, size_t ws_size, hipStream_t stream) {
    static int grid = 0;
    if (grid == 0) {
        if (n_in != 24 || out_size != NTOK * DM || ws_size < WS_END) { fprintf(stderr, "kernel_launch: unexpected shapes: n_in %d out %d ws %zu (need %zu)\n", n_in, out_size, ws_size, (size_t)WS_END); grid = -1; return; }
        int dev = 0, cus = 0, per_cu = 0;
        hipGetDevice(&dev); hipDeviceGetAttribute(&cus, hipDeviceAttributeMultiprocessorCount, dev);
        if (hipFuncSetAttribute((const void*)fwd_megakernel, hipFuncAttributeMaxDynamicSharedMemorySize, LDS_BYTES) != hipSuccess) { fprintf(stderr, "kernel_launch: hipFuncSetAttribute failed\n"); grid = -1; return; }
        if (hipOccupancyMaxActiveBlocksPerMultiprocessor(&per_cu, (const void*)fwd_megakernel, NTHREADS, LDS_BYTES) != hipSuccess || per_cu < 1) { fprintf(stderr, "kernel_launch: occupancy query says %d blocks/CU\n", per_cu); per_cu = 1; }
        (void)hipGetLastError();
        grid = cus * (per_cu > 1 ? 1 : per_cu);
    }
    if (grid < 0) return;
    if (hipMemsetAsync((char*)d_ws + WS_BAR, 0, BAR_BYTES, stream) != hipSuccess) { fprintf(stderr, "kernel_launch: memset of barrier words failed\n"); return; }
    Params p{};
    for (int i = 0; i < 24; ++i) p.in[i] = (const float*)d_in[i];
    p.out = (float*)d_out; p.ws = (unsigned char*)d_ws;
    void* args[] = {&p};
    hipError_t e = hipLaunchCooperativeKernel((const void*)fwd_megakernel, dim3(grid), dim3(NTHREADS), args, LDS_BYTES, stream);
    if (e != hipSuccess) fprintf(stderr, "cooperative launch failed: %s (grid %d)\n", hipGetErrorString(e), grid);
}
```
